# Optimizing an MI355X kernel written in HIP

```python
import jax, jax.numpy as jnp
from jax import lax
import numpy as np

D_MODEL = 2048
BATCH = 4
SEQ = 8192
DEPTH = 1

CHUNK = 64
D_HGRN = D_MODEL // 2
HGRN_HEAD_DIM = 128
HGRN_HEADS = D_HGRN // HGRN_HEAD_DIM
D_POOL = D_MODEL - D_HGRN
POOL_WINDOWS = (2, 4, 8, 16)
N_POOL_GROUPS = len(POOL_WINDOWS)
POOL_GROUP_DIM = D_POOL // N_POOL_GROUPS
D_IN = 4 * D_HGRN + D_POOL
D_FF = 5632
RMS_EPS = 1e-6

kernel_name = "hymba_style_hgrn2_pool_macaron_block"


def rmsnorm(x, gain):
    x32 = x.astype(jnp.float32)
    y = x32 * lax.rsqrt(jnp.mean(x32 * x32, axis=-1, keepdims=True) + RMS_EPS)
    return (y * gain.astype(jnp.float32)).astype(x.dtype)


def swiglu(h, w_gate, w_up, w_down):
    return (jax.nn.silu(h @ w_gate) * (h @ w_up)) @ w_down


def hgrn2_mixer(q, f_logit, i, g, lb, g_norm):
    b_sz, t_len, _ = q.shape
    n_chunks = t_len // CHUNK
    f = lb.astype(jnp.float32) + (1.0 - lb.astype(jnp.float32)) * jax.nn.sigmoid(f_logit.astype(jnp.float32))
    log_f = jnp.log(f)
    k = 1.0 - f

    def to_chunks(a):
        a = a.astype(jnp.float32).reshape(b_sz, n_chunks, CHUNK, HGRN_HEADS, HGRN_HEAD_DIM)
        return a.transpose(1, 0, 3, 2, 4)

    qs, ks, vs, gs = to_chunks(q), to_chunks(k), to_chunks(i), to_chunks(log_f)
    causal = jnp.tril(jnp.ones((CHUNK, CHUNK), dtype=bool))

    def step(state, xs):
        qc, kc, vc, gc = xs
        cum = jnp.cumsum(gc, axis=2)
        diff = cum[:, :, :, None, :] - cum[:, :, None, :, :]
        decay = jnp.exp(jnp.where(causal[None, None, :, :, None], diff, -jnp.inf))
        scores = jnp.einsum('bhtd,bhsd,bhtsd->bhts', qc, kc, decay)
        o_intra = jnp.einsum('bhts,bhsv->bhtv', scores, vc)
        o_inter = jnp.einsum('bhtk,bhkv->bhtv', qc * jnp.exp(cum), state)
        last = cum[:, :, -1:, :]
        new_state = jnp.exp(last[:, :, 0, :])[..., None] * state + jnp.einsum(
            'bhsk,bhsv->bhkv', kc * jnp.exp(last - cum), vc)
        return new_state, o_intra + o_inter

    state0 = jnp.zeros((b_sz, HGRN_HEADS, HGRN_HEAD_DIM, HGRN_HEAD_DIM), jnp.float32)
    _, o = lax.scan(step, state0, (qs, ks, vs, gs))
    o = o.transpose(1, 0, 3, 2, 4).reshape(b_sz, t_len, HGRN_HEADS, HGRN_HEAD_DIM)
    o = rmsnorm(o, g_norm).reshape(b_sz, t_len, D_HGRN)
    return (o * jax.nn.silu(g.astype(jnp.float32))).astype(q.dtype)


def pool_mixer(u, w_pool, pool_scale):
    t_len = u.shape[1]
    u32 = u.astype(jnp.float32)
    pos = jnp.arange(t_len, dtype=jnp.int32)
    outs = []
    for gi, w in enumerate(POOL_WINDOWS):
        seg = u32[..., gi * POOL_GROUP_DIM:(gi + 1) * POOL_GROUP_DIM]
        csum = jnp.cumsum(seg, axis=1)
        csum_prev = jnp.pad(csum, ((0, 0), (w, 0), (0, 0)))[:, :t_len]
        count = jnp.minimum(pos + 1, w).astype(jnp.float32)[None, :, None]
        pooled = (csum - csum_prev) / count - seg
        outs.append(jnp.einsum('btc,cd->btd', pooled, w_pool[gi].astype(jnp.float32)))
    y = jnp.concatenate(outs, axis=-1) * pool_scale.astype(jnp.float32)
    return y.astype(u.dtype)


def setup_inputs(seed: int = 0) -> dict:
    key = jax.random.key(seed)
    ks = jax.random.split(key, 20)
    n = jax.random.normal

    def gain(k, d):
        return 1.0 + 0.02 * n(k, (DEPTH, d), jnp.float32)

    return {
        "x": n(ks[0], (BATCH, SEQ, D_MODEL), jnp.float32),
        "ffn1_pre_g": gain(ks[1], D_MODEL),
        "ffn1_w_gate": n(ks[2], (DEPTH, D_MODEL, D_FF), jnp.float32) * D_MODEL ** -0.5,
        "ffn1_w_up": n(ks[3], (DEPTH, D_MODEL, D_FF), jnp.float32) * D_MODEL ** -0.5,
        "ffn1_w_down": n(ks[4], (DEPTH, D_FF, D_MODEL), jnp.float32) * D_FF ** -0.5,
        "ffn1_post_g": gain(ks[5], D_MODEL),
        "mix_pre_g": gain(ks[6], D_MODEL),
        "w_in": n(ks[7], (DEPTH, D_MODEL, D_IN), jnp.float32) * D_MODEL ** -0.5,
        "hgrn_lb_logits": n(ks[8], (DEPTH + 1, D_HGRN), jnp.float32),
        "hgrn_g_norm": gain(ks[9], HGRN_HEAD_DIM),
        "w_pool": n(ks[10], (DEPTH, N_POOL_GROUPS, POOL_GROUP_DIM, POOL_GROUP_DIM), jnp.float32) * POOL_GROUP_DIM ** -0.5,
        "pool_scale": gain(ks[11], D_POOL),
        "w_out": n(ks[12], (DEPTH, D_MODEL, D_MODEL), jnp.float32) * D_MODEL ** -0.5,
        "mix_post_g": gain(ks[13], D_MODEL),
        "ffn2_pre_g": gain(ks[14], D_MODEL),
        "ffn2_w_gate": n(ks[15], (DEPTH, D_MODEL, D_FF), jnp.float32) * D_MODEL ** -0.5,
        "ffn2_w_up": n(ks[16], (DEPTH, D_MODEL, D_FF), jnp.float32) * D_MODEL ** -0.5,
        "ffn2_w_down": n(ks[17], (DEPTH, D_FF, D_MODEL), jnp.float32) * D_FF ** -0.5,
        "ffn2_post_g": gain(ks[18], D_MODEL),
    }


def reference(x, ffn1_pre_g, ffn1_w_gate, ffn1_w_up, ffn1_w_down, ffn1_post_g,
              mix_pre_g, w_in, hgrn_lb_logits, hgrn_g_norm, w_pool, pool_scale,
              w_out, mix_post_g, ffn2_pre_g, ffn2_w_gate, ffn2_w_up, ffn2_w_down,
              ffn2_post_g):
    lb_all = jnp.cumsum(jax.nn.softmax(hgrn_lb_logits.astype(jnp.float32), axis=0), axis=0)
    split_at = [D_HGRN, 2 * D_HGRN, 3 * D_HGRN, 4 * D_HGRN]
    for l in range(DEPTH):
        h = swiglu(rmsnorm(x, ffn1_pre_g[l]), ffn1_w_gate[l], ffn1_w_up[l], ffn1_w_down[l])
        x = x + 0.5 * rmsnorm(h, ffn1_post_g[l])
        h = rmsnorm(x, mix_pre_g[l])
        proj = h @ w_in[l]
        q, f_logit, i, g, u = jnp.split(proj, split_at, axis=-1)
        y_rec = hgrn2_mixer(q, f_logit, i, g, lb_all[l], hgrn_g_norm[l])
        y_pool = pool_mixer(u, w_pool[l], pool_scale[l])
        y = jnp.concatenate([y_rec, y_pool], axis=-1) @ w_out[l]
        x = x + rmsnorm(y, mix_post_g[l])
        h = swiglu(rmsnorm(x, ffn2_pre_g[l]), ffn2_w_gate[l], ffn2_w_up[l], ffn2_w_down[l])
        x = x + 0.5 * rmsnorm(h, ffn2_post_g[l])
    return x
```

```cpp
#include <hip/hip_runtime.h>
#include <hip/hip_cooperative_groups.h>
#include <cstdio>
#include <cstdint>
namespace cg = cooperative_groups;
namespace pg8 {
#define PG8_LAS __attribute__((address_space(3)))
typedef unsigned short bf16_t;
typedef short bf16x8 __attribute__((ext_vector_type(8)));
typedef float f32x4 __attribute__((ext_vector_type(4)));
typedef unsigned u32x4 __attribute__((ext_vector_type(4)));
constexpr int BM = 256, BK = 64, HALF = 128, HTB = HALF * BK * 2  , STAGE_BYTES = 8 * HTB, NXCD = 8, WGM = 8;

__host__ __device__ __forceinline__ int lds_byte(int r, int c) { const int st = (r >> 4) * 2 + (c >> 5), rr = r & 15, cc = c & 31, ob = rr * 64 + cc * 2; return st * 1024 + (ob ^ (((ob >> 9) & 1) << 5)); }
__host__ __device__ __forceinline__ void stage_rc(int b, int& R, int& C) { const int st = b / 1024, sb = b % 1024, swz = sb ^ (((sb >> 9) & 1) << 5); R = (st >> 1) * 16 + swz / 64; C = (st & 1) * 32 + (swz % 64) / 2; }
__host__ __device__ __forceinline__ int perm32(int rho) { const int n = rho >> 4, i = rho & 15; return 8 * (i >> 2) + 4 * n + (i & 3); }

struct Unit { int pm, pn; };
struct Gemm { const bf16_t* A; const bf16_t* Bt; int M, N, K; };

struct StaticOrder {
    int nM, nN, nwg, G, c, wgm;
    __host__ __device__ void init(int M, int N, int G_, int c_, int wgm_ = WGM) { nM = M / BM; nN = N / BM; nwg = nM * nN; G = G_; c = c_; wgm = wgm_; }
    __host__ __device__ bool next(int i, Unit& u) const {
        const long L = (long)i * G + c; if (L >= nwg) return false;
        int wgid = (int)L; { const int q = nwg / NXCD, r = nwg % NXCD, xcd = wgid % NXCD, off = wgid / NXCD; wgid = (xcd < r ? xcd * (q + 1) : r * (q + 1) + (xcd - r) * q) + off; }
        const int nig = wgm * nN, gid = wgid / nig, fm = gid * wgm, gsz = (nM - fm) < wgm ? (nM - fm) : wgm;
        u.pm = fm + ((wgid % nig) % gsz); u.pn = (wgid % nig) / gsz; return true;
    }
    __device__ __forceinline__ void a_ready(const Unit&) const {}
    __device__ __forceinline__ void done(const Unit&) const {}
};

typedef __bf16 bf16v2_t __attribute__((ext_vector_type(2)));
typedef float f32x2 __attribute__((ext_vector_type(2)));
__device__ __forceinline__ unsigned cvt_pk_bf16(float lo, float hi) { const bf16v2_t v = __builtin_convertvector((f32x2){lo, hi}, bf16v2_t); return __builtin_bit_cast(unsigned, v); }
typedef unsigned u32x2 __attribute__((ext_vector_type(2)));
__device__ __forceinline__ float fast_sigmoid(float v) { return __builtin_amdgcn_rcpf(1.0f + __expf(-v)); }
__device__ __forceinline__ float silu_f(float v) { return v * fast_sigmoid(v); }
__device__ __forceinline__ void store8(bf16_t* p, const f32x4 v0, const f32x4 v1) {
    u32x4 w; w.x = cvt_pk_bf16(v0[0], v0[1]); w.y = cvt_pk_bf16(v0[2], v0[3]); w.z = cvt_pk_bf16(v1[0], v1[1]); w.w = cvt_pk_bf16(v1[2], v1[3]);
    *(u32x4*)p = w;
}
struct EpiStore {
    static constexpr bool PERM = true, AFTER_DRAIN = false;
    bf16_t* O; int ldc;
    struct Pre {};
    __device__ __forceinline__ void prefetch(Pre&, const Unit&, int, int) const {}
    __device__ __forceinline__ void operator()(const f32x4 (&acc)[2][2][4][2], const Unit& u, int wr, int wc, int fr, int fq, const Pre&) const {
        const int row0 = u.pm * BM + wr * 64 + fr, col0 = u.pn * BM + wc * 32 + 8 * fq;
#pragma unroll
        for (int ai = 0; ai < 2; ++ai)
#pragma unroll
            for (int m = 0; m < 4; ++m) { bf16_t* rowp = O + (size_t)(row0 + ai * HALF + m * 16) * ldc + col0;
#pragma unroll
                for (int bj = 0; bj < 2; ++bj) store8(rowp + bj * HALF, acc[ai][bj][m][0], acc[ai][bj][m][1]); }
    }
};
struct EpiSwiglu {
    static constexpr bool PERM = true, AFTER_DRAIN = false;
    bf16_t* O; int ldc; const float* rs;
    struct Pre { float r[2][4]; };
    __device__ __forceinline__ void prefetch(Pre& p, const Unit& u, int wr, int fr) const {
#pragma unroll
        for (int ai = 0; ai < 2; ++ai)
#pragma unroll
            for (int m = 0; m < 4; ++m) p.r[ai][m] = rs[u.pm * BM + wr * 64 + fr + ai * HALF + m * 16];
    }
    __device__ __forceinline__ void operator()(const f32x4 (&acc)[2][2][4][2], const Unit& u, int wr, int wc, int fr, int fq, const Pre& pre) const {
        const int row0 = u.pm * BM + wr * 64 + fr, col0 = u.pn * HALF + wc * 32 + 8 * fq;
#pragma unroll
        for (int ai = 0; ai < 2; ++ai)
#pragma unroll
            for (int m = 0; m < 4; ++m) { bf16_t* rowp = O + (size_t)(row0 + ai * HALF + m * 16) * ldc + col0;
                f32x4 h0, h1; const float r = pre.r[ai][m];
#pragma unroll
                for (int j = 0; j < 4; ++j) { h0[j] = silu_f(r * acc[ai][0][m][0][j]) * (r * acc[ai][1][m][0][j]); h1[j] = silu_f(r * acc[ai][0][m][1][j]) * (r * acc[ai][1][m][1][j]); }
                store8(rowp, h0, h1); }
    }
};
struct EpiWin {
    static constexpr bool PERM = true, AFTER_DRAIN = false;
    bf16_t *Q, *Kk, *LF, *V, *G, *U; const float* lbl; const float* rs;
    struct Pre { float r[2][4]; };
    __device__ __forceinline__ void prefetch(Pre& p, const Unit& u, int wr, int fr) const {
#pragma unroll
        for (int ai = 0; ai < 2; ++ai)
#pragma unroll
            for (int m = 0; m < 4; ++m) p.r[ai][m] = rs[u.pm * BM + wr * 64 + fr + ai * HALF + m * 16];
    }
    __device__ __forceinline__ void operator()(const f32x4 (&acc)[2][2][4][2], const Unit& u, int wr, int wc, int fr, int fq, const Pre& pre) const {
        const int seg = u.pn >> 2, colt = (u.pn & 3) * BM;
        const int row0 = u.pm * BM + wr * 64 + fr, col0 = colt + wc * 32 + 8 * fq;
        if (seg == 1) {
            f32x4 lb[2][2], om[2][2];
#pragma unroll
            for (int bj = 0; bj < 2; ++bj)
#pragma unroll
                for (int n = 0; n < 2; ++n) { const f32x4 a0 = *(const f32x4*)(lbl + col0 + bj * HALF + 4 * n), a1 = *(const f32x4*)(lbl + 1024 + col0 + bj * HALF + 4 * n);
#pragma unroll
                    for (int j = 0; j < 4; ++j) { const float l = 1.0f / (1.0f + __expf(a1[j] - a0[j])); lb[bj][n][j] = l; om[bj][n][j] = 1.0f - l; } }
#pragma unroll
            for (int ai = 0; ai < 2; ++ai)
#pragma unroll
                for (int m = 0; m < 4; ++m) { const size_t ro = (size_t)(row0 + ai * HALF + m * 16) * 1024 + col0; const float r = pre.r[ai][m];
#pragma unroll
                    for (int bj = 0; bj < 2; ++bj) { f32x4 k0, k1, l0, l1;
#pragma unroll
                        for (int j = 0; j < 4; ++j) {
                            const float z0 = r * acc[ai][bj][m][0][j], z1 = r * acc[ai][bj][m][1][j];
                            const float s0 = fast_sigmoid(z0), s1 = fast_sigmoid(z1);
                            const float f0 = lb[bj][0][j] + om[bj][0][j] * s0, f1 = lb[bj][1][j] + om[bj][1][j] * s1;
                            k0[j] = om[bj][0][j] * (1.0f - s0); k1[j] = om[bj][1][j] * (1.0f - s1);
                            l0[j] = __logf(f0); l1[j] = __logf(f1); }
                        store8(Kk + ro + bj * HALF, k0, k1); store8(LF + ro + bj * HALF, l0, l1); } }
        } else {
            bf16_t* O = seg == 0 ? Q : (seg == 2 ? V : (seg == 3 ? G : U));
#pragma unroll
            for (int ai = 0; ai < 2; ++ai)
#pragma unroll
                for (int m = 0; m < 4; ++m) { bf16_t* rowp = O + (size_t)(row0 + ai * HALF + m * 16) * 1024 + col0; const float r = pre.r[ai][m];
#pragma unroll
                    for (int bj = 0; bj < 2; ++bj) { f32x4 v0 = acc[ai][bj][m][0] * r, v1 = acc[ai][bj][m][1] * r;
                        if (seg == 3) {
#pragma unroll
                            for (int j = 0; j < 4; ++j) { v0[j] = silu_f(v0[j]); v1[j] = silu_f(v1[j]); } }
                        store8(rowp + bj * HALF, v0, v1); } }
        }
    }
};

template <class Epi, class Sched, bool ALIGN_EPI = false, bool SP2 = false>
__device__ __forceinline__ void gemm_phase(PG8_LAS unsigned char* lds, const Gemm g, const Sched& S, const Epi& E) {
    const int tid = threadIdx.x, wid = __builtin_amdgcn_readfirstlane(tid >> 6), lane = tid & 63, wr = wid >> 2, wc = wid & 3, fr = lane & 15, fq = lane >> 4;
    const int K = g.K, nt = K / BK;
    unsigned voffA[2], voffB[2];
#pragma unroll
    for (int i = 0; i < 2; ++i) { int R, C; stage_rc(tid * 16 + i * 8192, R, C); const int Rb = Epi::PERM ? ((R & ~31) + perm32(R & 31)) : R;
        voffA[i] = (unsigned)(R * K + C) * 2u; voffB[i] = (unsigned)(Rb * K + C) * 2u; }
    const size_t kstep = (size_t)(BK * 2);
    const size_t hstep = (size_t)HALF * K * 2;
    const size_t tstep = 2 * hstep;
    const unsigned ldsw = (unsigned)wid * 1024u;
    const int aoff = lds_byte(wr * 64 + fr, fq * 8), boff = lds_byte(wc * 32 + fr, fq * 8);
#define PG8_SA(b, h) (((b) * 2 + (h)) * HTB)
#define PG8_SB(b, h) ((4 + (b) * 2 + (h)) * HTB)
#define PG8_STAGE(bufoff, gbase, voff) do { _Pragma("unroll") for (int _i = 0; _i < 2; ++_i) \
        __builtin_amdgcn_global_load_lds((const unsigned*)((const char*)(gbase) + (voff)[_i]), (PG8_LAS unsigned*)(lds + (bufoff) + ldsw + _i * 8192), 16, 0, 0); } while (0)
#define PG8_LDA(dst, b, h) do { _Pragma("unroll") for (int m = 0; m < 4; ++m) _Pragma("unroll") for (int k = 0; k < 2; ++k) dst[m][k] = *(const PG8_LAS bf16x8*)(lds + PG8_SA(b, h) + aoff + m * 2048 + k * 1024); } while (0)
#define PG8_LDB(dst, b, h) do { _Pragma("unroll") for (int n = 0; n < 2; ++n) _Pragma("unroll") for (int k = 0; k < 2; ++k) dst[n][k] = *(const PG8_LAS bf16x8*)(lds + PG8_SB(b, h) + boff + n * 2048 + k * 1024); } while (0)
#define PG8_MMA(ai, bj, At, Bt) do { __builtin_amdgcn_s_setprio(1); _Pragma("unroll") for (int m = 0; m < 4; ++m) _Pragma("unroll") for (int n = 0; n < 2; ++n) _Pragma("unroll") for (int k = 0; k < 2; ++k) \
        acc[ai][bj][m][n] = __builtin_amdgcn_mfma_f32_16x16x32_bf16(Bt[n][k], At[m][k], acc[ai][bj][m][n], 0, 0, 0); __builtin_amdgcn_s_setprio(0); } while (0)
#define PG8_WAIT_V(n) asm volatile("s_waitcnt vmcnt(" #n ")" ::: "memory")
#define PG8_WAIT_L(n) asm volatile("s_waitcnt lgkmcnt(" #n ")" ::: "memory")
#define PG8_BAR __builtin_amdgcn_s_barrier()
#define PG8_SCHED __builtin_amdgcn_sched_barrier(0)
    Unit cur, nxt; int ui = 0;
    if (!S.next(0, cur)) return;
    f32x4 acc[2][2][4][2];
#pragma unroll
    for (int a = 0; a < 2; ++a)
#pragma unroll
        for (int b = 0; b < 2; ++b)
#pragma unroll
            for (int m = 0; m < 4; ++m)
#pragma unroll
                for (int n = 0; n < 2; ++n) acc[a][b][m][n] = (f32x4){0.f, 0.f, 0.f, 0.f};
    bf16x8 At[4][2], B0[2][2], B1[2][2];
    const char* cA = (const char*)g.A + (size_t)cur.pm * tstep; const char* cB = (const char*)g.Bt + (size_t)cur.pn * tstep;
    S.a_ready(cur);
    typename Epi::Pre pre; E.prefetch(pre, cur, wr, fr);
    if constexpr (SP2) {
        PG8_STAGE(PG8_SB(0, 0), cB, voffB); PG8_STAGE(PG8_SB(0, 1), cB + hstep, voffB); PG8_STAGE(PG8_SA(0, 0), cA, voffA); PG8_STAGE(PG8_SA(0, 1), cA + hstep, voffA);
        if (wr == 1) PG8_BAR;
        PG8_WAIT_V(2); PG8_BAR;
        PG8_STAGE(PG8_SB(1, 0), cB + kstep, voffB); PG8_STAGE(PG8_SA(1, 0), cA + kstep, voffA); PG8_STAGE(PG8_SB(1, 1), cB + hstep + kstep, voffB);
        PG8_WAIT_V(6); PG8_BAR;
    } else {
        PG8_STAGE(PG8_SB(0, 0), cB, voffB); PG8_STAGE(PG8_SA(0, 0), cA, voffA); PG8_STAGE(PG8_SB(0, 1), cB + hstep, voffB); PG8_STAGE(PG8_SA(0, 1), cA + hstep, voffA);
        if (wr == 1) PG8_BAR;
        PG8_WAIT_V(4); PG8_BAR;
        PG8_STAGE(PG8_SB(1, 0), cB + kstep, voffB); PG8_STAGE(PG8_SA(1, 0), cA + kstep, voffA); PG8_STAGE(PG8_SB(1, 1), cB + hstep + kstep, voffB);
        PG8_WAIT_V(6); PG8_BAR;
    }
    for (;;) {
        const bool has_next = S.next(ui + 1, nxt);
        const char* nA = has_next ? (const char*)g.A + (size_t)nxt.pm * tstep : cA; const char* nB = has_next ? (const char*)g.Bt + (size_t)nxt.pn * tstep : cB;
        for (int t = 0; t < nt; t += 2) {
            const bool last = (t == nt - 2);
            const char* a1 = cA + (size_t)(t + 1) * kstep;
            const char* a2 = last ? nA : cA + (size_t)(t + 2) * kstep; const char* b2 = last ? nB : cB + (size_t)(t + 2) * kstep;
            const char* a3 = a2 + kstep; const char* b3 = b2 + kstep;
            if (last && has_next) S.a_ready(nxt);
            if constexpr (SP2) {
            PG8_LDB(B0, 0, 0); PG8_LDB(B1, 0, 1); PG8_SCHED; PG8_LDA(At, 0, 0); PG8_STAGE(PG8_SA(1, 1), a1 + hstep, voffA);
            PG8_WAIT_V(8); PG8_WAIT_L(0); PG8_BAR; PG8_MMA(0, 0, At, B0); PG8_MMA(0, 1, At, B1); PG8_BAR; PG8_SCHED;
            PG8_LDA(At, 0, 1); PG8_STAGE(PG8_SB(0, 0), b2, voffB); PG8_STAGE(PG8_SB(0, 1), b2 + hstep, voffB); PG8_STAGE(PG8_SA(0, 0), a2, voffA);
            PG8_WAIT_V(8); PG8_WAIT_L(0); PG8_BAR; PG8_MMA(1, 0, At, B0); PG8_MMA(1, 1, At, B1); PG8_BAR; PG8_SCHED;
            PG8_LDB(B0, 1, 0); PG8_LDB(B1, 1, 1); PG8_SCHED; PG8_LDA(At, 1, 0); PG8_STAGE(PG8_SA(0, 1), a2 + hstep, voffA);
            PG8_WAIT_V(8); PG8_WAIT_L(0); PG8_BAR; PG8_MMA(0, 0, At, B0); PG8_MMA(0, 1, At, B1); PG8_BAR; PG8_SCHED;
            PG8_LDA(At, 1, 1); PG8_STAGE(PG8_SB(1, 0), b3, voffB); PG8_STAGE(PG8_SB(1, 1), b3 + hstep, voffB); PG8_STAGE(PG8_SA(1, 0), a3, voffA);
            PG8_WAIT_V(8); PG8_WAIT_L(0); PG8_BAR; PG8_MMA(1, 0, At, B0); PG8_MMA(1, 1, At, B1); PG8_BAR; PG8_SCHED;
            } else {
            PG8_LDB(B0, 0, 0); PG8_SCHED; PG8_LDA(At, 0, 0); PG8_STAGE(PG8_SA(1, 1), a1 + hstep, voffA);
            PG8_WAIT_L(8); PG8_BAR; PG8_WAIT_L(0); PG8_MMA(0, 0, At, B0); PG8_BAR; PG8_SCHED;
            PG8_LDB(B1, 0, 1); PG8_STAGE(PG8_SB(0, 0), b2, voffB);
            PG8_BAR; PG8_WAIT_L(0); PG8_MMA(0, 1, At, B1); PG8_BAR;
            PG8_LDA(At, 0, 1); PG8_STAGE(PG8_SA(0, 0), a2, voffA);
            PG8_BAR; PG8_WAIT_L(0); PG8_MMA(1, 0, At, B0); PG8_BAR; PG8_SCHED;
            PG8_STAGE(PG8_SB(0, 1), b2 + hstep, voffB);
            PG8_WAIT_V(6); PG8_BAR; PG8_MMA(1, 1, At, B1); PG8_BAR;
            PG8_LDB(B0, 1, 0); PG8_SCHED; PG8_LDA(At, 1, 0); PG8_STAGE(PG8_SA(0, 1), a2 + hstep, voffA);
            PG8_WAIT_L(8); PG8_BAR; PG8_WAIT_L(0); PG8_MMA(0, 0, At, B0); PG8_BAR; PG8_SCHED;
            PG8_LDB(B1, 1, 1); PG8_STAGE(PG8_SB(1, 0), b3, voffB);
            PG8_BAR; PG8_WAIT_L(0); PG8_MMA(0, 1, At, B1); PG8_BAR;
            PG8_LDA(At, 1, 1); PG8_STAGE(PG8_SA(1, 0), a3, voffA);
            PG8_BAR; PG8_WAIT_L(0); PG8_MMA(1, 0, At, B0); PG8_BAR; PG8_SCHED;
            PG8_STAGE(PG8_SB(1, 1), b3 + hstep, voffB);
            PG8_WAIT_V(6); PG8_BAR; PG8_MMA(1, 1, At, B1); PG8_BAR;
            }
        }
        if constexpr (ALIGN_EPI) { if (wr == 0) PG8_BAR; }
        if constexpr (!Epi::AFTER_DRAIN) { E(acc, cur, wr, wc, fr, fq, pre); S.done(cur); }
        if (!has_next) break;
#pragma unroll
        for (int a = 0; a < 2; ++a)
#pragma unroll
            for (int b = 0; b < 2; ++b)
#pragma unroll
                for (int m = 0; m < 4; ++m)
#pragma unroll
                    for (int n = 0; n < 2; ++n) acc[a][b][m][n] = (f32x4){0.f, 0.f, 0.f, 0.f};
        cur = nxt; cA = nA; cB = nB; ++ui;
        E.prefetch(pre, cur, wr, fr);
        if constexpr (ALIGN_EPI) { if (wr == 1) PG8_BAR; }
    }
    PG8_WAIT_V(0);
    if constexpr (!ALIGN_EPI) { if (wr == 0) PG8_BAR; }
    PG8_BAR;
#undef PG8_SA
#undef PG8_SB
#undef PG8_STAGE
#undef PG8_LDA
#undef PG8_LDB
#undef PG8_MMA
#undef PG8_WAIT_V
#undef PG8_WAIT_L
#undef PG8_BAR
#undef PG8_SCHED
}
}
using pg8::bf16_t; using pg8::bf16x8; using pg8::f32x4; using pg8::u32x4; using pg8::f32x2; using pg8::u32x2;
#define LAS __attribute__((address_space(3)))
constexpr int NWAVES = 8, NTHR = NWAVES * 64;
constexpr int BATCH = 4, SEQ = 8192, DM = 2048, M = BATCH * SEQ, FF = 5632, DH = 1024, HD = 128, NH = 8, DP = 1024, DIN = 5120;
constexpr int CH = 64, NCH = SEQ / CH, NUNIT = BATCH * NH * NCH;
constexpr int NPOOLU = (M / 64) * 4;
constexpr float RMS_EPS = 1e-6f;
constexpr size_t MiB = 1u << 20;
constexpr size_t WS_WGU1 = 1 * MiB, WS_WD1 = 45 * MiB, WS_WIN = 67 * MiB, WS_WOUT = 87 * MiB, WS_WPOOL = 95 * MiB, WS_WGU2 = 96 * MiB, WS_WD2 = 140 * MiB;
constexpr size_t WS_H = 162 * MiB;
constexpr size_t WS_Q = 162 * MiB, WS_K = 226 * MiB, WS_LF = 290 * MiB, WS_V = 354 * MiB, WS_G = 418 * MiB;
constexpr size_t WS_Y = 514 * MiB;
constexpr size_t WS_S = WS_Y;
constexpr size_t WS_XN = 642 * MiB;
constexpr size_t WS_YCAT = 770 * MiB;
constexpr size_t WS_U = 898 * MiB;
constexpr size_t WS_DEC = 962 * MiB;
constexpr size_t WS_RS = 964 * MiB;
constexpr size_t WS_END = 965 * MiB;
constexpr int LDS_BYTES = 147456;

__device__ __forceinline__ float bf2f(unsigned short b) { return __builtin_bit_cast(float, (unsigned)b << 16); }
__device__ __forceinline__ float bflo(unsigned w) { return __builtin_bit_cast(float, w << 16); }
__device__ __forceinline__ float bfhi(unsigned w) { return __builtin_bit_cast(float, w & 0xffff0000u); }
__device__ __forceinline__ unsigned pk2(float lo, float hi) { return pg8::cvt_pk_bf16(lo, hi); }
__device__ __forceinline__ float wave_sum(float v) {
#pragma unroll
    for (int o = 1; o < 64; o <<= 1) v += __shfl_xor(v, o);
    return v;
}
#define LDS_WAIT() asm volatile("s_waitcnt lgkmcnt(0)" ::: "memory")

constexpr int P0_PITCH = 68, P0_SCR_BYTES = 64 * P0_PITCH * 4;
__device__ __forceinline__ void p0_transpose_item(const float* W, int K, int N, bf16_t* WT, int k0, int n0, int drow0, LAS float* scr, int lane, const float* gk) {
    const int lr = lane >> 4, lc = lane & 15;
    f32x4 v[16];
#pragma unroll
    for (int i = 0; i < 16; ++i) v[i] = *(const f32x4*)(W + (size_t)(k0 + 4 * i + lr) * N + n0 + 4 * lc);
#pragma unroll
    for (int i = 0; i < 16; ++i) { const float gsc = gk ? gk[k0 + 4 * i + lr] : 1.0f; *(LAS f32x4*)(scr + (4 * i + lr) * P0_PITCH + 4 * lc) = v[i] * gsc; }
    LDS_WAIT(); asm volatile("" ::: "memory");
    const int c = lane & 7;
#pragma unroll
    for (int j = 0; j < 8; ++j) { const int n = (lane >> 3) + 8 * j; const LAS float* s = scr + (8 * c) * P0_PITCH + n;
        u32x4 o; o.x = pk2(s[0 * P0_PITCH], s[1 * P0_PITCH]); o.y = pk2(s[2 * P0_PITCH], s[3 * P0_PITCH]); o.z = pk2(s[4 * P0_PITCH], s[5 * P0_PITCH]); o.w = pk2(s[6 * P0_PITCH], s[7 * P0_PITCH]);
        *(u32x4*)(WT + (size_t)(drow0 + n) * K + k0 + 8 * c) = o; }
    LDS_WAIT(); asm volatile("" ::: "memory");
}
__device__ __forceinline__ void p0_matrix_item(const float* W, int K, int N, bf16_t* WT, int mode, int item, LAS float* scr, int lane, const float* gk = nullptr) {
    const int nblk = N / 64, kb = item / nblk, nb = item % nblk, n0 = 64 * nb;
    const int drow0 = mode == 0 ? n0 : (256 * (n0 >> 7) + (n0 & 127) + (mode == 2 ? 128 : 0));
    p0_transpose_item(W, K, N, WT, 64 * kb, n0, drow0, scr, lane, gk);
}

__device__ __forceinline__ void rows_first(const float* __restrict__ x, bf16_t* __restrict__ XB, float* __restrict__ RS, int gw, int NGW, int lane) {
    for (int m0 = gw; m0 < M; m0 += 2 * NGW) {
        const int m1 = (m0 + NGW < M) ? m0 + NGW : m0;
        f32x4 v[2][8]; float s[2] = {0.f, 0.f};
#pragma unroll
        for (int q = 0; q < 2; ++q) { const f32x4* xr = (const f32x4*)(x + (size_t)(q ? m1 : m0) * DM) + lane;
#pragma unroll
            for (int j = 0; j < 8; ++j) v[q][j] = xr[64 * j]; }
#pragma unroll
        for (int q = 0; q < 2; ++q) {
#pragma unroll
            for (int j = 0; j < 8; ++j) s[q] += (v[q][j].x * v[q][j].x + v[q][j].y * v[q][j].y) + (v[q][j].z * v[q][j].z + v[q][j].w * v[q][j].w);
            u32x2* o = (u32x2*)(XB + (size_t)(q ? m1 : m0) * DM) + lane;
#pragma unroll
            for (int j = 0; j < 8; ++j) { u32x2 w; w.x = pk2(v[q][j].x, v[q][j].y); w.y = pk2(v[q][j].z, v[q][j].w); o[64 * j] = w; } }
        const float r0 = rsqrtf(wave_sum(s[0]) * (1.f / DM) + RMS_EPS), r1 = rsqrtf(wave_sum(s[1]) * (1.f / DM) + RMS_EPS);
        if (lane == 0) { RS[m0] = r0; RS[m1] = r1; }
    }
}
template <bool FINAL>
__device__ __forceinline__ void rows_res(const float* xf, const bf16_t* Y, float coef, const float* g1, bf16_t* XB, float* RS, float* out, int gw, int NGW, int lane) {
    for (int m = gw; m < M; m += NGW) {
        const u32x2* yr = (const u32x2*)(Y + (size_t)m * DM) + lane;
        f32x4 v[8], y[8]; float s = 0.f;
        if (xf) { const f32x4* xr = (const f32x4*)(xf + (size_t)m * DM) + lane;
#pragma unroll
            for (int j = 0; j < 8; ++j) v[j] = xr[64 * j];
        } else { const u32x2* xr = (const u32x2*)(XB + (size_t)m * DM) + lane;
#pragma unroll
            for (int j = 0; j < 8; ++j) { const u32x2 w = xr[64 * j]; v[j] = (f32x4){bflo(w.x), bfhi(w.x), bflo(w.y), bfhi(w.y)}; } }
#pragma unroll
        for (int j = 0; j < 8; ++j) { const u32x2 w = yr[64 * j]; y[j] = (f32x4){bflo(w.x), bfhi(w.x), bflo(w.y), bfhi(w.y)};
            s += (y[j].x * y[j].x + y[j].y * y[j].y) + (y[j].z * y[j].z + y[j].w * y[j].w); }
        const float r1 = coef * rsqrtf(wave_sum(s) * (1.f / DM) + RMS_EPS);
        float s2 = 0.f;
#pragma unroll
        for (int j = 0; j < 8; ++j) { const f32x4 gg = *((const f32x4*)g1 + lane + 64 * j); v[j] = v[j] + y[j] * r1 * gg;
            s2 += (v[j].x * v[j].x + v[j].y * v[j].y) + (v[j].z * v[j].z + v[j].w * v[j].w); }
        if (FINAL) { f32x4* xw = (f32x4*)(out + (size_t)m * DM) + lane;
#pragma unroll
            for (int j = 0; j < 8; ++j) xw[64 * j] = v[j];
        } else {
            u32x2* o = (u32x2*)(XB + (size_t)m * DM) + lane;
#pragma unroll
            for (int j = 0; j < 8; ++j) { u32x2 w; w.x = pk2(v[j].x, v[j].y); w.y = pk2(v[j].z, v[j].w); o[64 * j] = w; }
            const float r2 = rsqrtf(wave_sum(s2) * (1.f / DM) + RMS_EPS);
            if (lane == 0) RS[m] = r2;
        }
    }
}

__device__ __forceinline__ unsigned off_b(unsigned row, unsigned ch) { return 256u * row + 16u * (ch ^ (((row & 3u) << 2) | ((row >> 2) & 3u))); }
__device__ __forceinline__ unsigned row_addr16(unsigned lane, unsigned rb, unsigned s) { return off_b((lane & 15) + 16 * rb, 4 * s + (lane >> 4)); }
__device__ __forceinline__ unsigned tr_addr16(unsigned lane, unsigned c, unsigned ks, unsigned t) { const unsigned g = lane >> 4, q = (lane & 15) >> 2, p = lane & 3; return off_b(32 * ks + 8 * g + 4 * t + q, 2 * c + (p >> 1)) + 8 * (p & 1); }
typedef short s16x4 __attribute__((ext_vector_type(4)));
__device__ __forceinline__ bf16x8 tile_tr(LAS unsigned char* tile, unsigned lane, unsigned c, unsigned ks) {
    const s16x4 lo = __builtin_amdgcn_ds_read_tr16_b64_v4i16((LAS s16x4*)(tile + tr_addr16(lane, c, ks, 0)));
    const s16x4 hi = __builtin_amdgcn_ds_read_tr16_b64_v4i16((LAS s16x4*)(tile + tr_addr16(lane, c, ks, 1)));
    return (bf16x8){lo[0], lo[1], lo[2], lo[3], hi[0], hi[1], hi[2], hi[3]};
}
__device__ __forceinline__ bf16x8 tile_row(LAS unsigned char* tile, unsigned lane, unsigned rb, unsigned s) { return *(const LAS bf16x8*)(tile + row_addr16(lane, rb, s)); }
__device__ __forceinline__ f32x4 mfma16(bf16x8 a, bf16x8 b, f32x4 c) { return __builtin_amdgcn_mfma_f32_16x16x32_bf16(a, b, c, 0, 0, 0); }

__device__ __forceinline__ void tile64_ld(const bf16_t* g, u32x4 (&r)[2], int tid) {
#pragma unroll
    for (int it = 0; it < 2; ++it) { const int n = tid + NTHR * it, row = n >> 4, ch = n & 15; r[it] = *(const u32x4*)(g + (size_t)row * 1024 + ch * 8); }
}
__device__ __forceinline__ void tile64_st(const u32x4 (&r)[2], LAS unsigned char* tile, int tid) {
#pragma unroll
    for (int it = 0; it < 2; ++it) { const int n = tid + NTHR * it, row = n >> 4, ch = n & 15; *(LAS u32x4*)(tile + off_b(row, ch)) = r[it]; }
}
struct ScanOut { float cl[8][2]; float pre0, pre1, tot0, tot1, mid0, mid1; };
__device__ __forceinline__ void chunk_scan(LAS unsigned char* TL, LAS float* PART, int dp, int oct, ScanOut& o) {
    float r0 = 0.f, r1 = 0.f;
#pragma unroll
    for (int i = 0; i < 8; ++i) { const unsigned w = *(const LAS unsigned*)(TL + off_b(8 * oct + i, dp >> 2) + 4 * (dp & 3)); r0 += bflo(w); r1 += bfhi(w); o.cl[i][0] = r0; o.cl[i][1] = r1; }
    *(LAS f32x2*)(PART + oct * 128 + 2 * dp) = (f32x2){r0, r1};
    __syncthreads();
    o.pre0 = o.pre1 = o.tot0 = o.tot1 = o.mid0 = o.mid1 = 0.f;
#pragma unroll
    for (int q = 0; q < 8; ++q) { const f32x2 p = *(const LAS f32x2*)(PART + q * 128 + 2 * dp); if (q < oct) { o.pre0 += p.x; o.pre1 += p.y; } if (q < 4) { o.mid0 += p.x; o.mid1 += p.y; } o.tot0 += p.x; o.tot1 += p.y; }
}

__device__ __forceinline__ size_t unit_goff(int unit) { const int b = unit >> 10, h = (unit >> 7) & 7, c = unit & 127; return (size_t)(b * SEQ + c * CH) * 1024 + h * HD; }
__device__ __forceinline__ void hgrn_pass1_phase(LAS unsigned char* lds, int bx, int G, const bf16_t* Kk, const bf16_t* LF, const bf16_t* V, bf16_t* S, float* DEC, int tid) {
    LAS unsigned char* TK = lds; LAS unsigned char* TL = lds + 16384; LAS unsigned char* TV = lds + 32768; LAS float* PART = (LAS float*)(lds + 49152);
    const int dp = tid & 63, oct = tid >> 6;
    const unsigned lane = tid & 63, wave = tid >> 6, fr = lane & 15, g4 = lane >> 4;
    u32x4 rk[2], rl[2], rv[2];
    if (bx < NUNIT) { const size_t go = unit_goff(bx); tile64_ld(Kk + go, rk, tid); tile64_ld(LF + go, rl, tid); tile64_ld(V + go, rv, tid); }
    for (int unit = bx; unit < NUNIT; unit += G) {
        tile64_st(rk, TK, tid); tile64_st(rl, TL, tid); tile64_st(rv, TV, tid);
        __syncthreads();
        if (unit + G < NUNIT) { const size_t go = unit_goff(unit + G); tile64_ld(Kk + go, rk, tid); tile64_ld(LF + go, rl, tid); tile64_ld(V + go, rv, tid); }
        ScanOut sc; chunk_scan(TL, PART, dp, oct, sc);
#pragma unroll
        for (int i = 0; i < 8; ++i) { LAS unsigned* p = (LAS unsigned*)(TK + off_b(8 * oct + i, dp >> 2) + 4 * (dp & 3)); const unsigned w = *p;
            const float e0 = __expf(sc.tot0 - (sc.pre0 + sc.cl[i][0])), e1 = __expf(sc.tot1 - (sc.pre1 + sc.cl[i][1]));
            *p = pk2(bflo(w) * e0, bfhi(w) * e1); }
        if (oct == 0) *(f32x2*)(DEC + (size_t)unit * HD + 2 * dp) = (f32x2){__expf(sc.tot0), __expf(sc.tot1)};
        __syncthreads();
        f32x4 acc[8];
#pragma unroll
        for (int cb = 0; cb < 8; ++cb) acc[cb] = (f32x4){0.f, 0.f, 0.f, 0.f};
#pragma unroll
        for (int ks = 0; ks < 2; ++ks) { const bf16x8 bk = tile_tr(TK, lane, wave, ks);
#pragma unroll
            for (int cb = 0; cb < 8; ++cb) { const bf16x8 av = tile_tr(TV, lane, cb, ks); acc[cb] = mfma16(av, bk, acc[cb]); } }
        bf16_t* sp = S + (size_t)unit * (HD * HD) + (16 * wave + fr) * HD + 4 * g4;
#pragma unroll
        for (int cb = 0; cb < 8; ++cb) { u32x2 w; w.x = pk2(acc[cb][0], acc[cb][1]); w.y = pk2(acc[cb][2], acc[cb][3]); *(u32x2*)(sp + 16 * cb) = w; }
        __syncthreads();
    }
}

__device__ __forceinline__ void pool_unit(LAS unsigned char* lds, int pu, const bf16_t* U, const bf16_t* WpT, const float* pscale, bf16_t* YCAT, int tid) {
    const int tile = pu >> 2, gi = pu & 3, row0 = tile * 64, w = 2 << gi, pos0 = row0 & (SEQ - 1);
    LAS unsigned char* TP = lds;
    LAS unsigned char* TU = lds + 33792;
    const int cp = tid & 127, tq = tid >> 7, tbeg = 16 * tq, nrow = 64 + w - 1;
    { const bf16_t* ug = U + ((ptrdiff_t)row0 - (w - 1)) * 1024 + 256 * gi;
      for (int n = tid; n < nrow * 32; n += NTHR) { const int r = n >> 5, ch = n & 31; u32x4 v = (u32x4){0u, 0u, 0u, 0u};
          if (pos0 - (w - 1) + r >= 0) v = *(const u32x4*)(ug + (ptrdiff_t)r * 1024 + ch * 8);
          *(LAS u32x4*)(TU + r * 528 + ch * 16) = v; } }
    __syncthreads();
    {   const LAS unsigned char* tu = TU + (w - 1) * 528 + cp * 4;
        float r0 = 0.f, r1 = 0.f;
        for (int j = 1; j < w; ++j) { const unsigned x = *(const LAS unsigned*)(tu + (tbeg - j) * 528); r0 += bflo(x); r1 += bfhi(x); }
#pragma unroll 4
        for (int i = 0; i < 16; ++i) { const int t = tbeg + i; const unsigned x = *(const LAS unsigned*)(tu + t * 528); const float c0 = bflo(x), c1 = bfhi(x);
            r0 += c0; r1 += c1; const int cn = pos0 + t + 1; const float inv = 1.0f / (float)(cn < w ? cn : w);
            *(LAS unsigned*)(TP + t * 528 + cp * 4) = pk2(r0 * inv - c0, r1 * inv - c1);
            const unsigned xo = *(const LAS unsigned*)(tu + (t - w + 1) * 528); r0 -= bflo(xo); r1 -= bfhi(xo); } }
    __syncthreads();
    const unsigned lane = tid & 63, wave = tid >> 6, fr = lane & 15, g4 = lane >> 4;
    f32x4 acc[2][4];
#pragma unroll
    for (int a = 0; a < 2; ++a)
#pragma unroll
        for (int t = 0; t < 4; ++t) acc[a][t] = (f32x4){0.f, 0.f, 0.f, 0.f};
    const bf16_t* wb = WpT + (size_t)gi * 65536 + (size_t)(32 * wave + fr) * 256 + 8 * g4;
#pragma unroll 2
    for (int ks = 0; ks < 8; ++ks) {
        bf16x8 a[2], bq[4];
#pragma unroll
        for (int nbi = 0; nbi < 2; ++nbi) a[nbi] = *(const bf16x8*)(wb + nbi * 16 * 256 + 32 * ks);
#pragma unroll
        for (int tb = 0; tb < 4; ++tb) bq[tb] = *(const LAS bf16x8*)(TP + (16 * tb + fr) * 528 + 64 * ks + 16 * g4);
#pragma unroll
        for (int nbi = 0; nbi < 2; ++nbi)
#pragma unroll
            for (int tb = 0; tb < 4; ++tb) acc[nbi][tb] = mfma16(a[nbi], bq[tb], acc[nbi][tb]);
    }
#pragma unroll
    for (int nbi = 0; nbi < 2; ++nbi) { const int n = 32 * wave + 16 * nbi + 4 * g4; const f32x4 sc = *(const f32x4*)(pscale + 256 * gi + n);
#pragma unroll
        for (int tb = 0; tb < 4; ++tb) { const f32x4 o = acc[nbi][tb] * sc; u32x2 wv; wv.x = pk2(o[0], o[1]); wv.y = pk2(o[2], o[3]);
            *(u32x2*)(YCAT + (size_t)(row0 + 16 * tb + fr) * DM + DH + 256 * gi + n) = wv; } }
    __syncthreads();
}

#ifndef SCAN_U
#define SCAN_U 8
#endif
__device__ __forceinline__ void hgrn_scan(bf16_t* S, const float* DEC, int gtid, int gthreads) {
    for (int idx = gtid; idx < BATCH * NH * HD * HD / 4; idx += gthreads) {
        const int bh = idx >> 12, rem = idx & 4095, dk = rem >> 5;
        bf16_t* sp = S + (size_t)bh * NCH * (HD * HD) + rem * 4; const float* dp = DEC + (size_t)bh * NCH * HD + dk;
        f32x4 s = (f32x4){0.f, 0.f, 0.f, 0.f};
        for (int c0 = 0; c0 < NCH; c0 += SCAN_U) {
            u32x2 bw[SCAN_U]; float d[SCAN_U];
#pragma unroll
            for (int i = 0; i < SCAN_U; ++i) { bw[i] = *(const u32x2*)(sp + (size_t)(c0 + i) * (HD * HD)); d[i] = dp[(c0 + i) * HD]; }
#pragma unroll
            for (int i = 0; i < SCAN_U; ++i) { u32x2 o; o.x = pk2(s[0], s[1]); o.y = pk2(s[2], s[3]); *(u32x2*)(sp + (size_t)(c0 + i) * (HD * HD)) = o;
                s = s * d[i] + (f32x4){bflo(bw[i].x), bfhi(bw[i].x), bflo(bw[i].y), bfhi(bw[i].y)}; }
        }
    }
}

__device__ __forceinline__ void state_ld(const bf16_t* sg, u32x4 (&r)[4], int tid) {
#pragma unroll
    for (int it = 0; it < 4; ++it) { const int n = tid + NTHR * it, row = n >> 4, ch = n & 15; r[it] = *(const u32x4*)(sg + row * HD + ch * 8); }
}
__device__ __forceinline__ void hgrn_pass3_phase(LAS unsigned char* lds, int bx, int G, const bf16_t* Q, const bf16_t* Kk, const bf16_t* LF, const bf16_t* V, const bf16_t* Gt, const bf16_t* S,
                                                 const float* gnorm, bf16_t* YCAT, int tid) {
    LAS unsigned char* TQ = lds; LAS unsigned char* TK = lds + 16384; LAS unsigned char* TL = lds + 32768; LAS unsigned char* TV = lds + 49152; LAS unsigned char* TS = lds + 65536;
    LAS unsigned char* TA = lds + 98304; LAS float* PART = (LAS float*)(lds + 108544); LAS float* RED = (LAS float*)(lds + 112640); LAS unsigned char* TG = lds + 114688;
    const int dp = tid & 63, oct = tid >> 6;
    const unsigned lane = tid & 63, wave = tid >> 6, fr = lane & 15, g4 = lane >> 4;
    f32x4 gn[4];
#pragma unroll
    for (int cb = 0; cb < 4; ++cb) gn[cb] = *(const f32x4*)(gnorm + 16 * (4 * (wave >> 2) + cb) + 4 * g4);
    u32x4 rq[2], rk[2], rl[2], rv[2], rs[4], rg[2];
    if (bx < NUNIT) { const size_t go = unit_goff(bx); tile64_ld(Q + go, rq, tid); tile64_ld(Kk + go, rk, tid); tile64_ld(LF + go, rl, tid); tile64_ld(V + go, rv, tid); tile64_ld(Gt + go, rg, tid); state_ld(S + (size_t)bx * (HD * HD), rs, tid); }
    for (int unit = bx; unit < NUNIT; unit += G) {
        const int b = unit >> 10, h = (unit >> 7) & 7, c = unit & 127;
        const int row0 = b * SEQ + c * CH;
        tile64_st(rq, TQ, tid); tile64_st(rk, TK, tid); tile64_st(rl, TL, tid); tile64_st(rv, TV, tid); tile64_st(rg, TG, tid);
#pragma unroll
        for (int it = 0; it < 4; ++it) { const int n = tid + NTHR * it, row = n >> 4, ch = n & 15; *(LAS u32x4*)(TS + off_b(row, ch)) = rs[it]; }
        __syncthreads();
        if (unit + G < NUNIT) { const size_t go = unit_goff(unit + G); tile64_ld(Q + go, rq, tid); tile64_ld(Kk + go, rk, tid); tile64_ld(LF + go, rl, tid); tile64_ld(V + go, rv, tid); tile64_ld(Gt + go, rg, tid); state_ld(S + (size_t)(unit + G) * (HD * HD), rs, tid); }
        ScanOut sc; chunk_scan(TL, PART, dp, oct, sc);
#pragma unroll
        for (int i = 0; i < 8; ++i) { const unsigned o = off_b(8 * oct + i, dp >> 2) + 4 * (dp & 3);
            const unsigned qw = *(const LAS unsigned*)(TQ + o), kw = *(const LAS unsigned*)(TK + o);
            const float c0 = sc.pre0 + sc.cl[i][0], c1 = sc.pre1 + sc.cl[i][1];
            const float q0 = bflo(qw), q1 = bfhi(qw);
            *(LAS unsigned*)(TQ + o) = pk2(q0 * __expf(c0 - sc.mid0), q1 * __expf(c1 - sc.mid1));
            *(LAS unsigned*)(TK + o) = pk2(bflo(kw) * __expf(sc.mid0 - c0), bfhi(kw) * __expf(sc.mid1 - c1));
            *(LAS unsigned*)(TL + o) = pk2(q0 * __expf(c0), q1 * __expf(c1)); }
        __syncthreads();
        {
            const unsigned tb = wave >> 1;
#pragma unroll
            for (int sbi = 0; sbi < 2; ++sbi) { const unsigned sb = 2 * (wave & 1) + sbi; f32x4 a = (f32x4){0.f, 0.f, 0.f, 0.f};
#pragma unroll
                for (int ks = 0; ks < 4; ++ks) a = mfma16(tile_row(TK, lane, sb, ks), tile_row(TQ, lane, tb, ks), a);
                const int t = 16 * tb + fr, s0 = 16 * sb + 4 * g4;
                u32x2 w; w.x = pk2(s0 <= t ? a[0] : 0.f, s0 + 1 <= t ? a[1] : 0.f); w.y = pk2(s0 + 2 <= t ? a[2] : 0.f, s0 + 3 <= t ? a[3] : 0.f);
                *(LAS u32x2*)(TA + t * 144 + s0 * 2) = w; }
        }
        __syncthreads();
        const unsigned tb = wave & 3, dvh = wave >> 2;
        const int t = 16 * tb + fr;
        f32x4 acc[4];
#pragma unroll
        for (int cb = 0; cb < 4; ++cb) acc[cb] = (f32x4){0.f, 0.f, 0.f, 0.f};
#pragma unroll
        for (int ks = 0; ks < 2; ++ks) { const bf16x8 bq = *(const LAS bf16x8*)(TA + (16 * tb + fr) * 144 + 64 * ks + 16 * g4);
#pragma unroll
            for (int cb = 0; cb < 4; ++cb) acc[cb] = mfma16(tile_tr(TV, lane, 4 * dvh + cb, ks), bq, acc[cb]); }
#pragma unroll
        for (int ks = 0; ks < 4; ++ks) { const bf16x8 bq = tile_row(TL, lane, tb, ks);
#pragma unroll
            for (int cb = 0; cb < 4; ++cb) acc[cb] = mfma16(tile_tr(TS, lane, 4 * dvh + cb, ks), bq, acc[cb]); }
        float ss = 0.f;
#pragma unroll
        for (int cb = 0; cb < 4; ++cb) ss += (acc[cb][0] * acc[cb][0] + acc[cb][1] * acc[cb][1]) + (acc[cb][2] * acc[cb][2] + acc[cb][3] * acc[cb][3]);
        ss += __shfl_xor(ss, 16); ss += __shfl_xor(ss, 32);
        if (g4 == 0) RED[dvh * 64 + 16 * tb + fr] = ss;
        __syncthreads();
        const float r = rsqrtf((RED[16 * tb + fr] + RED[64 + 16 * tb + fr]) * (1.f / HD) + RMS_EPS);
#pragma unroll
        for (int cb = 0; cb < 4; ++cb) { const int dv = 16 * (4 * dvh + cb) + 4 * g4;
            const u32x2 gw = *(const LAS u32x2*)(TG + off_b(t, dv >> 3) + 2 * (dv & 7));
            const f32x4 sg = (f32x4){bflo(gw.x), bfhi(gw.x), bflo(gw.y), bfhi(gw.y)};
            const f32x4 o = acc[cb] * r * gn[cb] * sg; u32x2 wv; wv.x = pk2(o[0], o[1]); wv.y = pk2(o[2], o[3]);
            *(u32x2*)(YCAT + (size_t)(row0 + t) * DM + h * HD + dv) = wv; }
        __syncthreads();
    }
}
#define XB_TMO      128
#define XB_XCNT(j)  (256  + 64 * (j))
#define XB_XSUB(j)  (1280 + 64 * (j))
#define XB_XGEN(j)  (2304 + 64 * (j))
#define XB_TOP      3328
#define XB_TOPGEN   3392
#define XCD_BAR_WORDS 3456
#define XB_SPIN_CAP (1u << 18)

__device__ __forceinline__ unsigned xb_ld(unsigned* p)              { return __hip_atomic_load(p, __ATOMIC_RELAXED, __HIP_MEMORY_SCOPE_AGENT); }
__device__ __forceinline__ unsigned xb_add(unsigned* p, unsigned v) { return __hip_atomic_fetch_add(p, v, __ATOMIC_RELAXED, __HIP_MEMORY_SCOPE_AGENT); }
__device__ __forceinline__ unsigned xb_xcc_id() { return (unsigned)__builtin_amdgcn_s_getreg((3 << 11) | 20) & 0xFu; }
#define XB_SPIN(cond, bar) do { unsigned _sp = 0; while (cond) { __builtin_amdgcn_s_sleep(1); \
    if ((++_sp & 255u) == 0u) { if (xb_ld(&(bar)[XB_TMO])) break; if (_sp > XB_SPIN_CAP) { atomicAdd(&(bar)[XB_TMO], 1u); break; } } } } while (0)

struct XcdBarrier {
    unsigned* bar; unsigned x;
    volatile LAS unsigned* st;
};

__device__ __forceinline__ XcdBarrier xcd_barrier_post(unsigned* bar, volatile LAS unsigned* st) {
    XcdBarrier b; b.bar = bar; b.x = xb_xcc_id(); b.st = st;
    if (threadIdx.x == 0) (void)xb_add(&bar[XB_XCNT(b.x)], 1u);
    return b;
}
__device__ __forceinline__ void xcd_barrier_complete(unsigned* bar, unsigned x, unsigned& nloc, unsigned& nx) {
    const unsigned G = gridDim.x * gridDim.y * gridDim.z;
    unsigned sum, cnt, mine, sp = 0u;
    for (;;) {
        sum = 0u; cnt = 0u; mine = 0u;
#pragma unroll
        for (unsigned j = 0; j < 16; ++j) { const unsigned c = xb_ld(&bar[XB_XCNT(j)]); sum += c; cnt += (c > 0u) ? 1u : 0u; mine = (j == x) ? c : mine; }
        if (sum == G) break;
        __builtin_amdgcn_s_sleep(1);
        if ((++sp & 255u) == 0u) { if (xb_ld(&bar[XB_TMO])) break; if (sp > XB_SPIN_CAP) { atomicAdd(&bar[XB_TMO], 1u); break; } }
    }
    nloc = mine > 0u ? mine : 1u; nx = cnt > 0u ? cnt : 1u;
}

__device__ __forceinline__ void xcd_barrier(const XcdBarrier& b) {
    asm volatile("s_waitcnt vmcnt(0)" ::: "memory");
    __syncthreads();
    if (threadIdx.x == 0) {
        unsigned* bar = b.bar;
        __builtin_amdgcn_s_waitcnt(0);
        unsigned nloc = b.st[0], nx = b.st[1];
        if (nloc == 0u) { xcd_barrier_complete(bar, b.x, nloc, nx); b.st[0] = nloc; b.st[1] = nx; }
        const unsigned old = xb_add(&bar[XB_XSUB(b.x)], 1u);
        const unsigned gen = old / nloc;
        if (old + 1u == (gen + 1u) * nloc) {
            __builtin_amdgcn_fence(__ATOMIC_RELEASE, "agent");
            asm volatile("s_waitcnt vmcnt(0)" ::: "memory");
            const unsigned og = xb_add(&bar[XB_TOP], 1u);
            const unsigned tg = og / nx;
            if (og + 1u == (tg + 1u) * nx) xb_add(&bar[XB_TOPGEN], 1u);
            else XB_SPIN(xb_ld(&bar[XB_TOPGEN]) == tg, bar);
            __builtin_amdgcn_fence(__ATOMIC_ACQUIRE, "agent");
            xb_add(&bar[XB_XGEN(b.x)], 1u);
            asm volatile("s_waitcnt vmcnt(0)" ::: "memory");
        } else {
            XB_SPIN(xb_ld(&bar[XB_XGEN(b.x)]) == gen, bar);
            __builtin_amdgcn_fence(__ATOMIC_ACQUIRE, "agent");
            asm volatile("s_waitcnt vmcnt(0)" ::: "memory");
        }
    }
    __syncthreads();
}

#ifndef MK_N_LAUNCHES
#define MK_N_LAUNCHES 1
#endif
#ifndef WGM_GU
#define WGM_GU 4
#endif
#ifndef WGM_D
#define WGM_D 4
#endif
#ifndef WGM_IN
#define WGM_IN 4
#endif
#ifndef WGM_OUT
#define WGM_OUT 4
#endif
constexpr int N_PHASES = 13;
struct Params { const float* in[19]; float* out; unsigned char* ws; int ph_lo, ph_hi, li, pad; };
__global__ void __launch_bounds__(NTHR, 2) fwd_megakernel(Params p) {
    extern __shared__ __attribute__((aligned(16))) unsigned char lds_raw[];
    LAS unsigned char* lds = (LAS unsigned char*)lds_raw;
    cg::grid_group grid = cg::this_grid();
    const int tid = threadIdx.x, lane = tid & 63, wave = __builtin_amdgcn_readfirstlane(tid >> 6);
    const int G = gridDim.x, bx = blockIdx.x;
    const int gw = bx * NWAVES + wave, NGW = G * NWAVES;
    unsigned char* ws = p.ws;
    const float* x = p.in[0];
    bf16_t* Wgu1 = (bf16_t*)(ws + WS_WGU1); bf16_t* Wd1 = (bf16_t*)(ws + WS_WD1); bf16_t* Win = (bf16_t*)(ws + WS_WIN); bf16_t* Wout = (bf16_t*)(ws + WS_WOUT);
    bf16_t* Wpool = (bf16_t*)(ws + WS_WPOOL); bf16_t* Wgu2 = (bf16_t*)(ws + WS_WGU2); bf16_t* Wd2 = (bf16_t*)(ws + WS_WD2);
    bf16_t* Hb = (bf16_t*)(ws + WS_H); bf16_t* Yb = (bf16_t*)(ws + WS_Y); bf16_t* XN = (bf16_t*)(ws + WS_XN); bf16_t* YCAT = (bf16_t*)(ws + WS_YCAT);
    bf16_t* Qb = (bf16_t*)(ws + WS_Q); bf16_t* Kb = (bf16_t*)(ws + WS_K); bf16_t* LFb = (bf16_t*)(ws + WS_LF); bf16_t* Vb = (bf16_t*)(ws + WS_V); bf16_t* Gb = (bf16_t*)(ws + WS_G);
    bf16_t* Ub = (bf16_t*)(ws + WS_U); bf16_t* Sb = (bf16_t*)(ws + WS_S); float* DEC = (float*)(ws + WS_DEC); float* RS = (float*)(ws + WS_RS);
    const int lo = p.ph_lo, hi = p.ph_hi;
#define IN(k) (lo <= (k) && (k) < hi)
#define SEAM(k) do { if (IN(k) && IN((k) + 1)) xcd_barrier(bar); } while (0)
    volatile LAS unsigned* bst = (volatile LAS unsigned*)(lds + LDS_BYTES - 64);
    if (tid < 16) bst[tid] = 0u;
    __syncthreads();
    XcdBarrier bar; bar.bar = (unsigned*)ws + p.li * XCD_BAR_WORDS; bar.x = 0; bar.st = nullptr;
    if (hi - lo > 1) bar = xcd_barrier_post((unsigned*)ws + p.li * XCD_BAR_WORDS, bst);
    if (lo == -12345) grid.sync();

    if (IN(0)) {
        LAS float* scr = (LAS float*)(lds + wave * P0_SCR_BYTES);
        constexpr int I_GU = (DM / 64) * (FF / 64), I_D = (FF / 64) * (DM / 64), I_IN = (DM / 64) * (DIN / 64), I_OUT = (DM / 64) * (DM / 64), I_P = (256 / 64) * (256 / 64);
        static_assert(NWAVES * P0_SCR_BYTES <= LDS_BYTES - 64, "prologue scratch");
        constexpr int NITEMS = 4 * I_GU + 2 * I_D + I_IN + I_OUT + 4 * I_P;
        for (int it = gw; it < NITEMS; it += NGW) {
            int r = it;
            if (r < I_GU) { p0_matrix_item(p.in[2], DM, FF, Wgu1, 1, r, scr, lane, p.in[1]); continue; } r -= I_GU;
            if (r < I_GU) { p0_matrix_item(p.in[3], DM, FF, Wgu1, 2, r, scr, lane, p.in[1]); continue; } r -= I_GU;
            if (r < I_D) { p0_matrix_item(p.in[4], FF, DM, Wd1, 0, r, scr, lane); continue; } r -= I_D;
            if (r < I_IN) { p0_matrix_item(p.in[7], DM, DIN, Win, 0, r, scr, lane, p.in[6]); continue; } r -= I_IN;
            if (r < I_OUT) { p0_matrix_item(p.in[12], DM, DM, Wout, 0, r, scr, lane); continue; } r -= I_OUT;
            if (r < 4 * I_P) { const int gi = r / I_P; p0_matrix_item(p.in[10] + (size_t)gi * 65536, 256, 256, Wpool + (size_t)gi * 65536, 0, r % I_P, scr, lane); continue; } r -= 4 * I_P;
            if (r < I_GU) { p0_matrix_item(p.in[15], DM, FF, Wgu2, 1, r, scr, lane, p.in[14]); continue; } r -= I_GU;
            if (r < I_GU) { p0_matrix_item(p.in[16], DM, FF, Wgu2, 2, r, scr, lane, p.in[14]); continue; } r -= I_GU;
            p0_matrix_item(p.in[17], FF, DM, Wd2, 0, r, scr, lane);
        }
        rows_first(x, XN, RS, gw, NGW, lane);
        __syncthreads();
    }
    SEAM(0);
    if (IN(1)) { pg8::Gemm g{XN, Wgu1, M, 2 * FF, DM}; pg8::StaticOrder S; S.init(M, 2 * FF, G, bx, WGM_GU); pg8::EpiSwiglu E{Hb, FF, RS};
        pg8::gemm_phase<pg8::EpiSwiglu, pg8::StaticOrder, true, true>(lds, g, S, E); }
    SEAM(1);
    if (IN(2)) { pg8::Gemm g{Hb, Wd1, M, DM, FF}; pg8::StaticOrder S; S.init(M, DM, G, bx, WGM_D); pg8::EpiStore E{Yb, DM};
        pg8::gemm_phase<pg8::EpiStore, pg8::StaticOrder, true, true>(lds, g, S, E); }
    SEAM(2);
    if (IN(3)) rows_res<false>(x, Yb, 0.5f, p.in[5], XN, RS, nullptr, gw, NGW, lane);
    SEAM(3);
    if (IN(4)) { pg8::Gemm g{XN, Win, M, DIN, DM}; pg8::StaticOrder S; S.init(M, DIN, G, bx, WGM_IN); pg8::EpiWin E{Qb, Kb, LFb, Vb, Gb, Ub, p.in[8], RS};
        pg8::gemm_phase<pg8::EpiWin, pg8::StaticOrder, true, true>(lds, g, S, E); }
    SEAM(4);
    if (IN(5)) {
        hgrn_pass1_phase(lds, bx, G, Kb, LFb, Vb, Sb, DEC, tid);
        for (int u = bx; u < NPOOLU; u += G) pool_unit(lds, u, Ub, Wpool, p.in[11], YCAT, tid);
    }
    SEAM(5);
    if (IN(6)) hgrn_scan(Sb, DEC, bx * NTHR + tid, G * NTHR);
    SEAM(6);
    if (IN(7)) hgrn_pass3_phase(lds, bx, G, Qb, Kb, LFb, Vb, Gb, Sb, p.in[9], YCAT, tid);
    SEAM(7);
    if (IN(8)) { pg8::Gemm g{YCAT, Wout, M, DM, DM}; pg8::StaticOrder S; S.init(M, DM, G, bx, WGM_OUT); pg8::EpiStore E{Yb, DM};
        pg8::gemm_phase<pg8::EpiStore, pg8::StaticOrder, true, true>(lds, g, S, E); }
    SEAM(8);
    if (IN(9)) rows_res<false>(nullptr, Yb, 1.0f, p.in[13], XN, RS, nullptr, gw, NGW, lane);
    SEAM(9);
    if (IN(10)) { pg8::Gemm g{XN, Wgu2, M, 2 * FF, DM}; pg8::StaticOrder S; S.init(M, 2 * FF, G, bx, WGM_GU); pg8::EpiSwiglu E{Hb, FF, RS};
        pg8::gemm_phase<pg8::EpiSwiglu, pg8::StaticOrder, true, true>(lds, g, S, E); }
    SEAM(10);
    if (IN(11)) { pg8::Gemm g{Hb, Wd2, M, DM, FF}; pg8::StaticOrder S; S.init(M, DM, G, bx, WGM_D); pg8::EpiStore E{Yb, DM};
        pg8::gemm_phase<pg8::EpiStore, pg8::StaticOrder, true, true>(lds, g, S, E); }
    SEAM(11);
    if (IN(12)) rows_res<true>(nullptr, Yb, 0.5f, p.in[18], XN, nullptr, p.out, gw, NGW, lane);
#undef IN
#undef SEAM
}

extern "C" void kernel_launch(void* const* d_in, const int* in_sizes, int n_in, void* d_out, int out_size, void* d_ws, size_t ws_size, hipStream_t stream) {
    static int grid = 0;
    if (grid == 0) {
        if (n_in != 19 || in_sizes[0] != M * DM || out_size != M * DM || ws_size < WS_END) { fprintf(stderr, "kernel_launch: unexpected shapes (n_in %d in0 %d out %d ws %zu)\n", n_in, n_in > 0 ? in_sizes[0] : -1, out_size, ws_size); grid = -1; return; }
        int dev = 0, cus = 0, per_cu = 0;
        (void)hipGetDevice(&dev); (void)hipDeviceGetAttribute(&cus, hipDeviceAttributeMultiprocessorCount, dev);
        if (hipFuncSetAttribute((const void*)fwd_megakernel, hipFuncAttributeMaxDynamicSharedMemorySize, LDS_BYTES) != hipSuccess) { fprintf(stderr, "kernel_launch: hipFuncSetAttribute failed\n"); grid = -1; return; }
        if (hipOccupancyMaxActiveBlocksPerMultiprocessor(&per_cu, (const void*)fwd_megakernel, NTHR, LDS_BYTES) != hipSuccess || per_cu < 1) { fprintf(stderr, "kernel_launch: occupancy query says %d\n", per_cu); per_cu = 1; }
        (void)hipGetLastError();
        grid = cus * per_cu;
    }
    if (grid < 0) return;
    Params p{};
    for (int i = 0; i < 19; ++i) p.in[i] = (const float*)d_in[i];
    p.out = (float*)d_out; p.ws = (unsigned char*)d_ws;
#if MK_N_LAUNCHES == 1
    (void)hipMemsetAsync(d_ws, 0, 65536, stream);
    void* args[] = {&p};
#ifdef PROBE_PHASE
#ifndef PROBE_END
#define PROBE_END PROBE_PHASE
#endif
    p.ph_lo = 0; p.ph_hi = PROBE_END + 1;
    (void)hipLaunchCooperativeKernel((const void*)fwd_megakernel, dim3(grid), dim3(NTHR), args, LDS_BYTES, stream);
    p.ph_lo = PROBE_PHASE; p.ph_hi = PROBE_END + 1; p.li = 1;
    (void)hipLaunchCooperativeKernel((const void*)fwd_megakernel, dim3(grid), dim3(NTHR), args, LDS_BYTES, stream);
    p.ph_lo = PROBE_END + 1; p.ph_hi = N_PHASES; p.li = 2;
    (void)hipLaunchCooperativeKernel((const void*)fwd_megakernel, dim3(grid), dim3(NTHR), args, LDS_BYTES, stream);
#else
    p.ph_lo = 0; p.ph_hi = N_PHASES;
    hipError_t e = hipLaunchCooperativeKernel((const void*)fwd_megakernel, dim3(grid), dim3(NTHR), args, LDS_BYTES, stream);
    if (e != hipSuccess) fprintf(stderr, "cooperative launch failed: %s (grid %d)\n", hipGetErrorString(e), grid);
#endif
#else
    for (int ph = 0; ph < N_PHASES; ++ph) { p.ph_lo = ph; p.ph_hi = ph + 1; hipLaunchKernelGGL(fwd_megakernel, dim3(grid), dim3(NTHR), LDS_BYTES, stream, p); }
#endif
}
```

```cpp
#include <hip/hip_runtime.h>
#include <hip/hip_cooperative_groups.h>
#include <cstdio>
#include <cstdint>
namespace cg = cooperative_groups;
namespace pg8 {
#define PG8_LAS __attribute__((address_space(3)))
typedef unsigned short bf16_t;
typedef short bf16x8 __attribute__((ext_vector_type(8)));
typedef float f32x4 __attribute__((ext_vector_type(4)));
typedef unsigned u32x4 __attribute__((ext_vector_type(4)));
constexpr int BM = 256, BK = 64, HALF = 128, HTB = HALF * BK * 2  , STAGE_BYTES = 8 * HTB, NXCD = 8, WGM = 8;

__host__ __device__ __forceinline__ int lds_byte(int r, int c) { const int st = (r >> 4) * 2 + (c >> 5), rr = r & 15, cc = c & 31, ob = rr * 64 + cc * 2; return st * 1024 + (ob ^ (((ob >> 9) & 1) << 5)); }
__host__ __device__ __forceinline__ void stage_rc(int b, int& R, int& C) { const int st = b / 1024, sb = b % 1024, swz = sb ^ (((sb >> 9) & 1) << 5); R = (st >> 1) * 16 + swz / 64; C = (st & 1) * 32 + (swz % 64) / 2; }
__host__ __device__ __forceinline__ int perm32(int rho) { const int n = rho >> 4, i = rho & 15; return 8 * (i >> 2) + 4 * n + (i & 3); }

struct Unit { int pm, pn; };
struct Gemm { const bf16_t* A; const bf16_t* Bt; int M, N, K; };

struct StaticOrder {
    int nM, nN, nwg, G, c, wgm;
    __host__ __device__ void init(int M, int N, int G_, int c_, int wgm_ = WGM) { nM = M / BM; nN = N / BM; nwg = nM * nN; G = G_; c = c_; wgm = wgm_; }
    __host__ __device__ bool next(int i, Unit& u) const {
        const long L = (long)i * G + c; if (L >= nwg) return false;
        int wgid = (int)L; { const int q = nwg / NXCD, r = nwg % NXCD, xcd = wgid % NXCD, off = wgid / NXCD; wgid = (xcd < r ? xcd * (q + 1) : r * (q + 1) + (xcd - r) * q) + off; }
        const int nig = wgm * nN, gid = wgid / nig, fm = gid * wgm, gsz = (nM - fm) < wgm ? (nM - fm) : wgm;
        u.pm = fm + ((wgid % nig) % gsz); u.pn = (wgid % nig) / gsz; return true;
    }
    __device__ __forceinline__ void a_ready(const Unit&) const {}
    __device__ __forceinline__ void done(const Unit&) const {}
};

typedef __bf16 bf16v2_t __attribute__((ext_vector_type(2)));
typedef float f32x2 __attribute__((ext_vector_type(2)));
__device__ __forceinline__ unsigned cvt_pk_bf16(float lo, float hi) { const bf16v2_t v = __builtin_convertvector((f32x2){lo, hi}, bf16v2_t); return __builtin_bit_cast(unsigned, v); }
typedef unsigned u32x2 __attribute__((ext_vector_type(2)));
__device__ __forceinline__ float fast_sigmoid(float v) { return __builtin_amdgcn_rcpf(1.0f + __expf(-v)); }
__device__ __forceinline__ float silu_f(float v) { return v * fast_sigmoid(v); }
__device__ __forceinline__ void store8(bf16_t* p, const f32x4 v0, const f32x4 v1) {
    u32x4 w; w.x = cvt_pk_bf16(v0[0], v0[1]); w.y = cvt_pk_bf16(v0[2], v0[3]); w.z = cvt_pk_bf16(v1[0], v1[1]); w.w = cvt_pk_bf16(v1[2], v1[3]);
    *(u32x4*)p = w;
}
struct EpiStore {
    static constexpr bool PERM = true, AFTER_DRAIN = false;
    bf16_t* O; int ldc;
    struct Pre {};
    __device__ __forceinline__ void prefetch(Pre&, const Unit&, int, int) const {}
    __device__ __forceinline__ void operator()(const f32x4 (&acc)[2][2][4][2], const Unit& u, int wr, int wc, int fr, int fq, const Pre&) const {
        const int row0 = u.pm * BM + wr * 64 + fr, col0 = u.pn * BM + wc * 32 + 8 * fq;
#pragma unroll
        for (int ai = 0; ai < 2; ++ai)
#pragma unroll
            for (int m = 0; m < 4; ++m) { bf16_t* rowp = O + (size_t)(row0 + ai * HALF + m * 16) * ldc + col0;
#pragma unroll
                for (int bj = 0; bj < 2; ++bj) store8(rowp + bj * HALF, acc[ai][bj][m][0], acc[ai][bj][m][1]); }
    }
};
struct EpiSwiglu {
    static constexpr bool PERM = true, AFTER_DRAIN = false;
    bf16_t* O; int ldc; const float* rs;
    struct Pre { float r[2][4]; };
    __device__ __forceinline__ void prefetch(Pre& p, const Unit& u, int wr, int fr) const {
#pragma unroll
        for (int ai = 0; ai < 2; ++ai)
#pragma unroll
            for (int m = 0; m < 4; ++m) p.r[ai][m] = rs[u.pm * BM + wr * 64 + fr + ai * HALF + m * 16];
    }
    __device__ __forceinline__ void operator()(const f32x4 (&acc)[2][2][4][2], const Unit& u, int wr, int wc, int fr, int fq, const Pre& pre) const {
        const int row0 = u.pm * BM + wr * 64 + fr, col0 = u.pn * HALF + wc * 32 + 8 * fq;
#pragma unroll
        for (int ai = 0; ai < 2; ++ai)
#pragma unroll
            for (int m = 0; m < 4; ++m) { bf16_t* rowp = O + (size_t)(row0 + ai * HALF + m * 16) * ldc + col0;
                f32x4 h0, h1; const float r = pre.r[ai][m];
#pragma unroll
                for (int j = 0; j < 4; ++j) { h0[j] = silu_f(r * acc[ai][0][m][0][j]) * (r * acc[ai][1][m][0][j]); h1[j] = silu_f(r * acc[ai][0][m][1][j]) * (r * acc[ai][1][m][1][j]); }
                store8(rowp, h0, h1); }
    }
};
struct EpiWin {
    static constexpr bool PERM = true, AFTER_DRAIN = false;
    bf16_t *Q, *Kk, *LF, *V, *G, *U; const float* lbl; const float* rs;
    struct Pre { float r[2][4]; };
    __device__ __forceinline__ void prefetch(Pre& p, const Unit& u, int wr, int fr) const {
#pragma unroll
        for (int ai = 0; ai < 2; ++ai)
#pragma unroll
            for (int m = 0; m < 4; ++m) p.r[ai][m] = rs[u.pm * BM + wr * 64 + fr + ai * HALF + m * 16];
    }
    __device__ __forceinline__ void operator()(const f32x4 (&acc)[2][2][4][2], const Unit& u, int wr, int wc, int fr, int fq, const Pre& pre) const {
        const int seg = u.pn >> 2, colt = (u.pn & 3) * BM;
        const int row0 = u.pm * BM + wr * 64 + fr, col0 = colt + wc * 32 + 8 * fq;
        if (seg == 1) {
            f32x4 lb[2][2], om[2][2];
#pragma unroll
            for (int bj = 0; bj < 2; ++bj)
#pragma unroll
                for (int n = 0; n < 2; ++n) { const f32x4 a0 = *(const f32x4*)(lbl + col0 + bj * HALF + 4 * n), a1 = *(const f32x4*)(lbl + 1024 + col0 + bj * HALF + 4 * n);
#pragma unroll
                    for (int j = 0; j < 4; ++j) { const float l = 1.0f / (1.0f + __expf(a1[j] - a0[j])); lb[bj][n][j] = l; om[bj][n][j] = 1.0f - l; } }
#pragma unroll
            for (int ai = 0; ai < 2; ++ai)
#pragma unroll
                for (int m = 0; m < 4; ++m) { const size_t ro = (size_t)(row0 + ai * HALF + m * 16) * 1024 + col0; const float r = pre.r[ai][m];
#pragma unroll
                    for (int bj = 0; bj < 2; ++bj) { f32x4 k0, k1, l0, l1;
#pragma unroll
                        for (int j = 0; j < 4; ++j) {
                            const float z0 = r * acc[ai][bj][m][0][j], z1 = r * acc[ai][bj][m][1][j];
                            const float s0 = fast_sigmoid(z0), s1 = fast_sigmoid(z1);
                            const float f0 = lb[bj][0][j] + om[bj][0][j] * s0, f1 = lb[bj][1][j] + om[bj][1][j] * s1;
                            k0[j] = om[bj][0][j] * (1.0f - s0); k1[j] = om[bj][1][j] * (1.0f - s1);
                            l0[j] = __logf(f0); l1[j] = __logf(f1); }
                        store8(Kk + ro + bj * HALF, k0, k1); store8(LF + ro + bj * HALF, l0, l1); } }
        } else {
            bf16_t* O = seg == 0 ? Q : (seg == 2 ? V : (seg == 3 ? G : U));
#pragma unroll
            for (int ai = 0; ai < 2; ++ai)
#pragma unroll
                for (int m = 0; m < 4; ++m) { bf16_t* rowp = O + (size_t)(row0 + ai * HALF + m * 16) * 1024 + col0; const float r = pre.r[ai][m];
#pragma unroll
                    for (int bj = 0; bj < 2; ++bj) { f32x4 v0 = acc[ai][bj][m][0] * r, v1 = acc[ai][bj][m][1] * r;
                        if (seg == 3) {
#pragma unroll
                            for (int j = 0; j < 4; ++j) { v0[j] = silu_f(v0[j]); v1[j] = silu_f(v1[j]); } }
                        store8(rowp + bj * HALF, v0, v1); } }
        }
    }
};

template <class Epi, class Sched, bool ALIGN_EPI = false, bool SP2 = false>
__device__ __forceinline__ void gemm_phase(PG8_LAS unsigned char* lds, const Gemm g, const Sched& S, const Epi& E) {
    const int tid = threadIdx.x, wid = __builtin_amdgcn_readfirstlane(tid >> 6), lane = tid & 63, wr = wid >> 2, wc = wid & 3, fr = lane & 15, fq = lane >> 4;
    const int K = g.K, nt = K / BK;
    unsigned voffA[2], voffB[2];
#pragma unroll
    for (int i = 0; i < 2; ++i) { int R, C; stage_rc(tid * 16 + i * 8192, R, C); const int Rb = Epi::PERM ? ((R & ~31) + perm32(R & 31)) : R;
        voffA[i] = (unsigned)(R * K + C) * 2u; voffB[i] = (unsigned)(Rb * K + C) * 2u; }
    const size_t kstep = (size_t)(BK * 2);
    const size_t hstep = (size_t)HALF * K * 2;
    const size_t tstep = 2 * hstep;
    const unsigned ldsw = (unsigned)wid * 1024u;
    const int aoff = lds_byte(wr * 64 + fr, fq * 8), boff = lds_byte(wc * 32 + fr, fq * 8);
#define PG8_SA(b, h) (((b) * 2 + (h)) * HTB)
#define PG8_SB(b, h) ((4 + (b) * 2 + (h)) * HTB)
#define PG8_STAGE(bufoff, gbase, voff) do { _Pragma("unroll") for (int _i = 0; _i < 2; ++_i) \
        __builtin_amdgcn_global_load_lds((const unsigned*)((const char*)(gbase) + (voff)[_i]), (PG8_LAS unsigned*)(lds + (bufoff) + ldsw + _i * 8192), 16, 0, 0); } while (0)
#define PG8_LDA(dst, b, h) do { _Pragma("unroll") for (int m = 0; m < 4; ++m) _Pragma("unroll") for (int k = 0; k < 2; ++k) dst[m][k] = *(const PG8_LAS bf16x8*)(lds + PG8_SA(b, h) + aoff + m * 2048 + k * 1024); } while (0)
#define PG8_LDB(dst, b, h) do { _Pragma("unroll") for (int n = 0; n < 2; ++n) _Pragma("unroll") for (int k = 0; k < 2; ++k) dst[n][k] = *(const PG8_LAS bf16x8*)(lds + PG8_SB(b, h) + boff + n * 2048 + k * 1024); } while (0)
#define PG8_MF1(ai, bj, At, Bt, m, n, k) do { acc[ai][bj][m][n] = __builtin_amdgcn_mfma_f32_16x16x32_bf16(Bt[n][k], At[m][k], acc[ai][bj][m][n], 0, 0, 0); __builtin_amdgcn_sched_barrier(0); } while (0)
#define PG8_MMA(ai, bj, At, Bt) do { __builtin_amdgcn_s_setprio(1); __builtin_amdgcn_sched_barrier(0); \
        PG8_MF1(ai, bj, At, Bt, 0, 0, 0); PG8_MF1(ai, bj, At, Bt, 0, 1, 0); PG8_MF1(ai, bj, At, Bt, 1, 1, 0); PG8_MF1(ai, bj, At, Bt, 1, 0, 0); \
        PG8_MF1(ai, bj, At, Bt, 2, 0, 0); PG8_MF1(ai, bj, At, Bt, 2, 1, 0); PG8_MF1(ai, bj, At, Bt, 3, 1, 0); PG8_MF1(ai, bj, At, Bt, 3, 0, 0); \
        PG8_MF1(ai, bj, At, Bt, 0, 0, 1); PG8_MF1(ai, bj, At, Bt, 0, 1, 1); PG8_MF1(ai, bj, At, Bt, 1, 1, 1); PG8_MF1(ai, bj, At, Bt, 1, 0, 1); \
        PG8_MF1(ai, bj, At, Bt, 2, 0, 1); PG8_MF1(ai, bj, At, Bt, 2, 1, 1); PG8_MF1(ai, bj, At, Bt, 3, 1, 1); PG8_MF1(ai, bj, At, Bt, 3, 0, 1); \
        __builtin_amdgcn_s_setprio(0); } while (0)
#define PG8_WAIT_V(n) asm volatile("s_waitcnt vmcnt(" #n ")" ::: "memory")
#define PG8_WAIT_L(n) asm volatile("s_waitcnt lgkmcnt(" #n ")" ::: "memory")
#define PG8_BAR __builtin_amdgcn_s_barrier()
#define PG8_SCHED __builtin_amdgcn_sched_barrier(0)
    Unit cur, nxt; int ui = 0;
    if (!S.next(0, cur)) return;
    f32x4 acc[2][2][4][2];
#pragma unroll
    for (int a = 0; a < 2; ++a)
#pragma unroll
        for (int b = 0; b < 2; ++b)
#pragma unroll
            for (int m = 0; m < 4; ++m)
#pragma unroll
                for (int n = 0; n < 2; ++n) acc[a][b][m][n] = (f32x4){0.f, 0.f, 0.f, 0.f};
    bf16x8 At[4][2], B0[2][2], B1[2][2];
    const char* cA = (const char*)g.A + (size_t)cur.pm * tstep; const char* cB = (const char*)g.Bt + (size_t)cur.pn * tstep;
    S.a_ready(cur);
    typename Epi::Pre pre; E.prefetch(pre, cur, wr, fr);
    if constexpr (SP2) {
        PG8_STAGE(PG8_SB(0, 0), cB, voffB); PG8_STAGE(PG8_SB(0, 1), cB + hstep, voffB); PG8_STAGE(PG8_SA(0, 0), cA, voffA); PG8_STAGE(PG8_SA(0, 1), cA + hstep, voffA);
        if (wr == 1) PG8_BAR;
        PG8_WAIT_V(2); PG8_BAR;
        PG8_STAGE(PG8_SB(1, 0), cB + kstep, voffB); PG8_STAGE(PG8_SA(1, 0), cA + kstep, voffA); PG8_STAGE(PG8_SB(1, 1), cB + hstep + kstep, voffB);
        PG8_WAIT_V(6); PG8_BAR;
    } else {
        PG8_STAGE(PG8_SB(0, 0), cB, voffB); PG8_STAGE(PG8_SA(0, 0), cA, voffA); PG8_STAGE(PG8_SB(0, 1), cB + hstep, voffB); PG8_STAGE(PG8_SA(0, 1), cA + hstep, voffA);
        if (wr == 1) PG8_BAR;
        PG8_WAIT_V(4); PG8_BAR;
        PG8_STAGE(PG8_SB(1, 0), cB + kstep, voffB); PG8_STAGE(PG8_SA(1, 0), cA + kstep, voffA); PG8_STAGE(PG8_SB(1, 1), cB + hstep + kstep, voffB);
        PG8_WAIT_V(6); PG8_BAR;
    }
    for (;;) {
        const bool has_next = S.next(ui + 1, nxt);
        const char* nA = has_next ? (const char*)g.A + (size_t)nxt.pm * tstep : cA; const char* nB = has_next ? (const char*)g.Bt + (size_t)nxt.pn * tstep : cB;
        for (int t = 0; t < nt; t += 2) {
            const bool last = (t == nt - 2);
            const char* a1 = cA + (size_t)(t + 1) * kstep;
            const char* a2 = last ? nA : cA + (size_t)(t + 2) * kstep; const char* b2 = last ? nB : cB + (size_t)(t + 2) * kstep;
            const char* a3 = a2 + kstep; const char* b3 = b2 + kstep;
            if (last && has_next) S.a_ready(nxt);
            if constexpr (SP2) {
            PG8_LDB(B0, 0, 0); PG8_LDB(B1, 0, 1); PG8_SCHED; PG8_LDA(At, 0, 0); PG8_STAGE(PG8_SA(1, 1), a1 + hstep, voffA);
            PG8_WAIT_V(8); PG8_WAIT_L(0); PG8_BAR; PG8_MMA(0, 0, At, B0); PG8_MMA(0, 1, At, B1); PG8_BAR; PG8_SCHED;
            PG8_LDA(At, 0, 1); PG8_STAGE(PG8_SB(0, 0), b2, voffB); PG8_STAGE(PG8_SB(0, 1), b2 + hstep, voffB); PG8_STAGE(PG8_SA(0, 0), a2, voffA);
            PG8_WAIT_V(8); PG8_WAIT_L(0); PG8_BAR; PG8_MMA(1, 0, At, B0); PG8_MMA(1, 1, At, B1); PG8_BAR; PG8_SCHED;
            PG8_LDB(B0, 1, 0); PG8_LDB(B1, 1, 1); PG8_SCHED; PG8_LDA(At, 1, 0); PG8_STAGE(PG8_SA(0, 1), a2 + hstep, voffA);
            PG8_WAIT_V(8); PG8_WAIT_L(0); PG8_BAR; PG8_MMA(0, 0, At, B0); PG8_MMA(0, 1, At, B1); PG8_BAR; PG8_SCHED;
            PG8_LDA(At, 1, 1); PG8_STAGE(PG8_SB(1, 0), b3, voffB); PG8_STAGE(PG8_SB(1, 1), b3 + hstep, voffB); PG8_STAGE(PG8_SA(1, 0), a3, voffA);
            PG8_WAIT_V(8); PG8_WAIT_L(0); PG8_BAR; PG8_MMA(1, 0, At, B0); PG8_MMA(1, 1, At, B1); PG8_BAR; PG8_SCHED;
            } else {
            PG8_LDB(B0, 0, 0); PG8_SCHED; PG8_LDA(At, 0, 0); PG8_STAGE(PG8_SA(1, 1), a1 + hstep, voffA);
            PG8_WAIT_L(8); PG8_BAR; PG8_WAIT_L(0); PG8_MMA(0, 0, At, B0); PG8_BAR; PG8_SCHED;
            PG8_LDB(B1, 0, 1); PG8_STAGE(PG8_SB(0, 0), b2, voffB);
            PG8_BAR; PG8_WAIT_L(0); PG8_MMA(0, 1, At, B1); PG8_BAR;
            PG8_LDA(At, 0, 1); PG8_STAGE(PG8_SA(0, 0), a2, voffA);
            PG8_BAR; PG8_WAIT_L(0); PG8_MMA(1, 0, At, B0); PG8_BAR; PG8_SCHED;
            PG8_STAGE(PG8_SB(0, 1), b2 + hstep, voffB);
            PG8_WAIT_V(6); PG8_BAR; PG8_MMA(1, 1, At, B1); PG8_BAR;
            PG8_LDB(B0, 1, 0); PG8_SCHED; PG8_LDA(At, 1, 0); PG8_STAGE(PG8_SA(0, 1), a2 + hstep, voffA);
            PG8_WAIT_L(8); PG8_BAR; PG8_WAIT_L(0); PG8_MMA(0, 0, At, B0); PG8_BAR; PG8_SCHED;
            PG8_LDB(B1, 1, 1); PG8_STAGE(PG8_SB(1, 0), b3, voffB);
            PG8_BAR; PG8_WAIT_L(0); PG8_MMA(0, 1, At, B1); PG8_BAR;
            PG8_LDA(At, 1, 1); PG8_STAGE(PG8_SA(1, 0), a3, voffA);
            PG8_BAR; PG8_WAIT_L(0); PG8_MMA(1, 0, At, B0); PG8_BAR; PG8_SCHED;
            PG8_STAGE(PG8_SB(1, 1), b3 + hstep, voffB);
            PG8_WAIT_V(6); PG8_BAR; PG8_MMA(1, 1, At, B1); PG8_BAR;
            }
        }
        if constexpr (ALIGN_EPI) { if (wr == 0) PG8_BAR; }
        if constexpr (!Epi::AFTER_DRAIN) { E(acc, cur, wr, wc, fr, fq, pre); S.done(cur); }
        if (!has_next) break;
#pragma unroll
        for (int a = 0; a < 2; ++a)
#pragma unroll
            for (int b = 0; b < 2; ++b)
#pragma unroll
                for (int m = 0; m < 4; ++m)
#pragma unroll
                    for (int n = 0; n < 2; ++n) acc[a][b][m][n] = (f32x4){0.f, 0.f, 0.f, 0.f};
        cur = nxt; cA = nA; cB = nB; ++ui;
        E.prefetch(pre, cur, wr, fr);
        if constexpr (ALIGN_EPI) { if (wr == 1) PG8_BAR; }
    }
    PG8_WAIT_V(0);
    if constexpr (!ALIGN_EPI) { if (wr == 0) PG8_BAR; }
    PG8_BAR;
#undef PG8_SA
#undef PG8_SB
#undef PG8_STAGE
#undef PG8_LDA
#undef PG8_LDB
#undef PG8_MMA
#undef PG8_MF1
#undef PG8_WAIT_V
#undef PG8_WAIT_L
#undef PG8_BAR
#undef PG8_SCHED
}
}
using pg8::bf16_t; using pg8::bf16x8; using pg8::f32x4; using pg8::u32x4; using pg8::f32x2; using pg8::u32x2;
#define LAS __attribute__((address_space(3)))
constexpr int NWAVES = 8, NTHR = NWAVES * 64;
constexpr int BATCH = 4, SEQ = 8192, DM = 2048, M = BATCH * SEQ, FF = 5632, DH = 1024, HD = 128, NH = 8, DP = 1024, DIN = 5120;
constexpr int CH = 64, NCH = SEQ / CH, NUNIT = BATCH * NH * NCH;
constexpr int NPOOLU = (M / 64) * 4;
constexpr float RMS_EPS = 1e-6f;
constexpr size_t MiB = 1u << 20;
constexpr size_t WS_WGU1 = 1 * MiB, WS_WD1 = 45 * MiB, WS_WIN = 67 * MiB, WS_WOUT = 87 * MiB, WS_WPOOL = 95 * MiB, WS_WGU2 = 96 * MiB, WS_WD2 = 140 * MiB;
constexpr size_t WS_H = 162 * MiB;
constexpr size_t WS_Q = 162 * MiB, WS_K = 226 * MiB, WS_LF = 290 * MiB, WS_V = 354 * MiB, WS_G = 418 * MiB;
constexpr size_t WS_Y = 514 * MiB;
constexpr size_t WS_S = WS_Y;
constexpr size_t WS_XN = 642 * MiB;
constexpr size_t WS_YCAT = 770 * MiB;
constexpr size_t WS_U = 898 * MiB;
constexpr size_t WS_DEC = 962 * MiB;
constexpr size_t WS_RS = 964 * MiB;
constexpr size_t WS_END = 965 * MiB;
constexpr int LDS_BYTES = 147456;

__device__ __forceinline__ float bf2f(unsigned short b) { return __builtin_bit_cast(float, (unsigned)b << 16); }
__device__ __forceinline__ float bflo(unsigned w) { return __builtin_bit_cast(float, w << 16); }
__device__ __forceinline__ float bfhi(unsigned w) { return __builtin_bit_cast(float, w & 0xffff0000u); }
__device__ __forceinline__ unsigned pk2(float lo, float hi) { return pg8::cvt_pk_bf16(lo, hi); }
__device__ __forceinline__ float wave_sum(float v) {
#pragma unroll
    for (int o = 1; o < 64; o <<= 1) v += __shfl_xor(v, o);
    return v;
}
#define LDS_WAIT() asm volatile("s_waitcnt lgkmcnt(0)" ::: "memory")

constexpr int P0_PITCH = 68, P0_SCR_BYTES = 64 * P0_PITCH * 4;
__device__ __forceinline__ void p0_transpose_item(const float* W, int K, int N, bf16_t* WT, int k0, int n0, int drow0, LAS float* scr, int lane, const float* gk) {
    const int lr = lane >> 4, lc = lane & 15;
    f32x4 v[16];
#pragma unroll
    for (int i = 0; i < 16; ++i) v[i] = *(const f32x4*)(W + (size_t)(k0 + 4 * i + lr) * N + n0 + 4 * lc);
#pragma unroll
    for (int i = 0; i < 16; ++i) { const float gsc = gk ? gk[k0 + 4 * i + lr] : 1.0f; *(LAS f32x4*)(scr + (4 * i + lr) * P0_PITCH + 4 * lc) = v[i] * gsc; }
    LDS_WAIT(); asm volatile("" ::: "memory");
    const int c = lane & 7;
#pragma unroll
    for (int j = 0; j < 8; ++j) { const int n = (lane >> 3) + 8 * j; const LAS float* s = scr + (8 * c) * P0_PITCH + n;
        u32x4 o; o.x = pk2(s[0 * P0_PITCH], s[1 * P0_PITCH]); o.y = pk2(s[2 * P0_PITCH], s[3 * P0_PITCH]); o.z = pk2(s[4 * P0_PITCH], s[5 * P0_PITCH]); o.w = pk2(s[6 * P0_PITCH], s[7 * P0_PITCH]);
        *(u32x4*)(WT + (size_t)(drow0 + n) * K + k0 + 8 * c) = o; }
    LDS_WAIT(); asm volatile("" ::: "memory");
}
__device__ __forceinline__ void p0_matrix_item(const float* W, int K, int N, bf16_t* WT, int mode, int item, LAS float* scr, int lane, const float* gk = nullptr) {
    const int nblk = N / 64, kb = item / nblk, nb = item % nblk, n0 = 64 * nb;
    const int drow0 = mode == 0 ? n0 : (256 * (n0 >> 7) + (n0 & 127) + (mode == 2 ? 128 : 0));
    p0_transpose_item(W, K, N, WT, 64 * kb, n0, drow0, scr, lane, gk);
}

__device__ __forceinline__ void rows_first(const float* __restrict__ x, bf16_t* __restrict__ XB, float* __restrict__ RS, int gw, int NGW, int lane) {
    for (int m0 = gw; m0 < M; m0 += 2 * NGW) {
        const int m1 = (m0 + NGW < M) ? m0 + NGW : m0;
        f32x4 v[2][8]; float s[2] = {0.f, 0.f};
#pragma unroll
        for (int q = 0; q < 2; ++q) { const f32x4* xr = (const f32x4*)(x + (size_t)(q ? m1 : m0) * DM) + lane;
#pragma unroll
            for (int j = 0; j < 8; ++j) v[q][j] = xr[64 * j]; }
#pragma unroll
        for (int q = 0; q < 2; ++q) {
#pragma unroll
            for (int j = 0; j < 8; ++j) s[q] += (v[q][j].x * v[q][j].x + v[q][j].y * v[q][j].y) + (v[q][j].z * v[q][j].z + v[q][j].w * v[q][j].w);
            u32x2* o = (u32x2*)(XB + (size_t)(q ? m1 : m0) * DM) + lane;
#pragma unroll
            for (int j = 0; j < 8; ++j) { u32x2 w; w.x = pk2(v[q][j].x, v[q][j].y); w.y = pk2(v[q][j].z, v[q][j].w); o[64 * j] = w; } }
        const float r0 = rsqrtf(wave_sum(s[0]) * (1.f / DM) + RMS_EPS), r1 = rsqrtf(wave_sum(s[1]) * (1.f / DM) + RMS_EPS);
        if (lane == 0) { RS[m0] = r0; RS[m1] = r1; }
    }
}
template <bool FINAL>
__device__ __forceinline__ void rows_res(const float* xf, const bf16_t* Y, float coef, const float* g1, bf16_t* XB, float* RS, float* out, int gw, int NGW, int lane) {
    for (int m = gw; m < M; m += NGW) {
        const u32x2* yr = (const u32x2*)(Y + (size_t)m * DM) + lane;
        f32x4 v[8], y[8]; float s = 0.f;
        if (xf) { const f32x4* xr = (const f32x4*)(xf + (size_t)m * DM) + lane;
#pragma unroll
            for (int j = 0; j < 8; ++j) v[j] = xr[64 * j];
        } else { const u32x2* xr = (const u32x2*)(XB + (size_t)m * DM) + lane;
#pragma unroll
            for (int j = 0; j < 8; ++j) { const u32x2 w = xr[64 * j]; v[j] = (f32x4){bflo(w.x), bfhi(w.x), bflo(w.y), bfhi(w.y)}; } }
#pragma unroll
        for (int j = 0; j < 8; ++j) { const u32x2 w = yr[64 * j]; y[j] = (f32x4){bflo(w.x), bfhi(w.x), bflo(w.y), bfhi(w.y)};
            s += (y[j].x * y[j].x + y[j].y * y[j].y) + (y[j].z * y[j].z + y[j].w * y[j].w); }
        const float r1 = coef * rsqrtf(wave_sum(s) * (1.f / DM) + RMS_EPS);
        float s2 = 0.f;
#pragma unroll
        for (int j = 0; j < 8; ++j) { const f32x4 gg = *((const f32x4*)g1 + lane + 64 * j); v[j] = v[j] + y[j] * r1 * gg;
            s2 += (v[j].x * v[j].x + v[j].y * v[j].y) + (v[j].z * v[j].z + v[j].w * v[j].w); }
        if (FINAL) { f32x4* xw = (f32x4*)(out + (size_t)m * DM) + lane;
#pragma unroll
            for (int j = 0; j < 8; ++j) xw[64 * j] = v[j];
        } else {
            u32x2* o = (u32x2*)(XB + (size_t)m * DM) + lane;
#pragma unroll
            for (int j = 0; j < 8; ++j) { u32x2 w; w.x = pk2(v[j].x, v[j].y); w.y = pk2(v[j].z, v[j].w); o[64 * j] = w; }
            const float r2 = rsqrtf(wave_sum(s2) * (1.f / DM) + RMS_EPS);
            if (lane == 0) RS[m] = r2;
        }
    }
}

__device__ __forceinline__ unsigned off_b(unsigned row, unsigned ch) { return 256u * row + 16u * (ch ^ (((row & 3u) << 2) | ((row >> 2) & 3u))); }
__device__ __forceinline__ unsigned row_addr16(unsigned lane, unsigned rb, unsigned s) { return off_b((lane & 15) + 16 * rb, 4 * s + (lane >> 4)); }
__device__ __forceinline__ unsigned tr_addr16(unsigned lane, unsigned c, unsigned ks, unsigned t) { const unsigned g = lane >> 4, q = (lane & 15) >> 2, p = lane & 3; return off_b(32 * ks + 8 * g + 4 * t + q, 2 * c + (p >> 1)) + 8 * (p & 1); }
typedef short s16x4 __attribute__((ext_vector_type(4)));
__device__ __forceinline__ bf16x8 tile_tr(LAS unsigned char* tile, unsigned lane, unsigned c, unsigned ks) {
    const s16x4 lo = __builtin_amdgcn_ds_read_tr16_b64_v4i16((LAS s16x4*)(tile + tr_addr16(lane, c, ks, 0)));
    const s16x4 hi = __builtin_amdgcn_ds_read_tr16_b64_v4i16((LAS s16x4*)(tile + tr_addr16(lane, c, ks, 1)));
    return (bf16x8){lo[0], lo[1], lo[2], lo[3], hi[0], hi[1], hi[2], hi[3]};
}
__device__ __forceinline__ bf16x8 tile_row(LAS unsigned char* tile, unsigned lane, unsigned rb, unsigned s) { return *(const LAS bf16x8*)(tile + row_addr16(lane, rb, s)); }
__device__ __forceinline__ f32x4 mfma16(bf16x8 a, bf16x8 b, f32x4 c) { return __builtin_amdgcn_mfma_f32_16x16x32_bf16(a, b, c, 0, 0, 0); }

__device__ __forceinline__ void tile64_ld(const bf16_t* g, u32x4 (&r)[2], int tid) {
#pragma unroll
    for (int it = 0; it < 2; ++it) { const int n = tid + NTHR * it, row = n >> 4, ch = n & 15; r[it] = *(const u32x4*)(g + (size_t)row * 1024 + ch * 8); }
}
__device__ __forceinline__ void tile64_st(const u32x4 (&r)[2], LAS unsigned char* tile, int tid) {
#pragma unroll
    for (int it = 0; it < 2; ++it) { const int n = tid + NTHR * it, row = n >> 4, ch = n & 15; *(LAS u32x4*)(tile + off_b(row, ch)) = r[it]; }
}
struct ScanOut { float cl[8][2]; float pre0, pre1, tot0, tot1, mid0, mid1; };
__device__ __forceinline__ void chunk_scan(LAS unsigned char* TL, LAS float* PART, int dp, int oct, ScanOut& o) {
    float r0 = 0.f, r1 = 0.f;
#pragma unroll
    for (int i = 0; i < 8; ++i) { const unsigned w = *(const LAS unsigned*)(TL + off_b(8 * oct + i, dp >> 2) + 4 * (dp & 3)); r0 += bflo(w); r1 += bfhi(w); o.cl[i][0] = r0; o.cl[i][1] = r1; }
    *(LAS f32x2*)(PART + oct * 128 + 2 * dp) = (f32x2){r0, r1};
    __syncthreads();
    o.pre0 = o.pre1 = o.tot0 = o.tot1 = o.mid0 = o.mid1 = 0.f;
#pragma unroll
    for (int q = 0; q < 8; ++q) { const f32x2 p = *(const LAS f32x2*)(PART + q * 128 + 2 * dp); if (q < oct) { o.pre0 += p.x; o.pre1 += p.y; } if (q < 4) { o.mid0 += p.x; o.mid1 += p.y; } o.tot0 += p.x; o.tot1 += p.y; }
}

__device__ __forceinline__ size_t unit_goff(int unit) { const int b = unit >> 10, h = (unit >> 7) & 7, c = unit & 127; return (size_t)(b * SEQ + c * CH) * 1024 + h * HD; }
__device__ __forceinline__ void hgrn_pass1_phase(LAS unsigned char* lds, int bx, int G, const bf16_t* Kk, const bf16_t* LF, const bf16_t* V, bf16_t* S, float* DEC, int tid) {
    LAS unsigned char* TK = lds; LAS unsigned char* TL = lds + 16384; LAS unsigned char* TV = lds + 32768; LAS float* PART = (LAS float*)(lds + 49152);
    const int dp = tid & 63, oct = tid >> 6;
    const unsigned lane = tid & 63, wave = tid >> 6, fr = lane & 15, g4 = lane >> 4;
    u32x4 rk[2], rl[2], rv[2];
    if (bx < NUNIT) { const size_t go = unit_goff(bx); tile64_ld(Kk + go, rk, tid); tile64_ld(LF + go, rl, tid); tile64_ld(V + go, rv, tid); }
    for (int unit = bx; unit < NUNIT; unit += G) {
        tile64_st(rk, TK, tid); tile64_st(rl, TL, tid); tile64_st(rv, TV, tid);
        __syncthreads();
        if (unit + G < NUNIT) { const size_t go = unit_goff(unit + G); tile64_ld(Kk + go, rk, tid); tile64_ld(LF + go, rl, tid); tile64_ld(V + go, rv, tid); }
        ScanOut sc; chunk_scan(TL, PART, dp, oct, sc);
#pragma unroll
        for (int i = 0; i < 8; ++i) { LAS unsigned* p = (LAS unsigned*)(TK + off_b(8 * oct + i, dp >> 2) + 4 * (dp & 3)); const unsigned w = *p;
            const float e0 = __expf(sc.tot0 - (sc.pre0 + sc.cl[i][0])), e1 = __expf(sc.tot1 - (sc.pre1 + sc.cl[i][1]));
            *p = pk2(bflo(w) * e0, bfhi(w) * e1); }
        if (oct == 0) *(f32x2*)(DEC + (size_t)unit * HD + 2 * dp) = (f32x2){__expf(sc.tot0), __expf(sc.tot1)};
        __syncthreads();
        f32x4 acc[8];
#pragma unroll
        for (int cb = 0; cb < 8; ++cb) acc[cb] = (f32x4){0.f, 0.f, 0.f, 0.f};
#pragma unroll
        for (int ks = 0; ks < 2; ++ks) { const bf16x8 bk = tile_tr(TK, lane, wave, ks);
#pragma unroll
            for (int cb = 0; cb < 8; ++cb) { const bf16x8 av = tile_tr(TV, lane, cb, ks); acc[cb] = mfma16(av, bk, acc[cb]); } }
        bf16_t* sp = S + (size_t)unit * (HD * HD) + (16 * wave + fr) * HD + 4 * g4;
#pragma unroll
        for (int cb = 0; cb < 8; ++cb) { u32x2 w; w.x = pk2(acc[cb][0], acc[cb][1]); w.y = pk2(acc[cb][2], acc[cb][3]); *(u32x2*)(sp + 16 * cb) = w; }
        __syncthreads();
    }
}

__device__ __forceinline__ void pool_unit(LAS unsigned char* lds, int pu, const bf16_t* U, const bf16_t* WpT, const float* pscale, bf16_t* YCAT, int tid) {
    const int tile = pu >> 2, gi = pu & 3, row0 = tile * 64, w = 2 << gi, pos0 = row0 & (SEQ - 1);
    LAS unsigned char* TP = lds;
    LAS unsigned char* TU = lds + 33792;
    const int cp = tid & 127, tq = tid >> 7, tbeg = 16 * tq, nrow = 64 + w - 1;
    { const bf16_t* ug = U + ((ptrdiff_t)row0 - (w - 1)) * 1024 + 256 * gi;
      for (int n = tid; n < nrow * 32; n += NTHR) { const int r = n >> 5, ch = n & 31; u32x4 v = (u32x4){0u, 0u, 0u, 0u};
          if (pos0 - (w - 1) + r >= 0) v = *(const u32x4*)(ug + (ptrdiff_t)r * 1024 + ch * 8);
          *(LAS u32x4*)(TU + r * 528 + ch * 16) = v; } }
    __syncthreads();
    {   const LAS unsigned char* tu = TU + (w - 1) * 528 + cp * 4;
        float r0 = 0.f, r1 = 0.f;
        for (int j = 1; j < w; ++j) { const unsigned x = *(const LAS unsigned*)(tu + (tbeg - j) * 528); r0 += bflo(x); r1 += bfhi(x); }
#pragma unroll 4
        for (int i = 0; i < 16; ++i) { const int t = tbeg + i; const unsigned x = *(const LAS unsigned*)(tu + t * 528); const float c0 = bflo(x), c1 = bfhi(x);
            r0 += c0; r1 += c1; const int cn = pos0 + t + 1; const float inv = 1.0f / (float)(cn < w ? cn : w);
            *(LAS unsigned*)(TP + t * 528 + cp * 4) = pk2(r0 * inv - c0, r1 * inv - c1);
            const unsigned xo = *(const LAS unsigned*)(tu + (t - w + 1) * 528); r0 -= bflo(xo); r1 -= bfhi(xo); } }
    __syncthreads();
    const unsigned lane = tid & 63, wave = tid >> 6, fr = lane & 15, g4 = lane >> 4;
    f32x4 acc[2][4];
#pragma unroll
    for (int a = 0; a < 2; ++a)
#pragma unroll
        for (int t = 0; t < 4; ++t) acc[a][t] = (f32x4){0.f, 0.f, 0.f, 0.f};
    const bf16_t* wb = WpT + (size_t)gi * 65536 + (size_t)(32 * wave + fr) * 256 + 8 * g4;
#pragma unroll 2
    for (int ks = 0; ks < 8; ++ks) {
        bf16x8 a[2], bq[4];
#pragma unroll
        for (int nbi = 0; nbi < 2; ++nbi) a[nbi] = *(const bf16x8*)(wb + nbi * 16 * 256 + 32 * ks);
#pragma unroll
        for (int tb = 0; tb < 4; ++tb) bq[tb] = *(const LAS bf16x8*)(TP + (16 * tb + fr) * 528 + 64 * ks + 16 * g4);
#pragma unroll
        for (int nbi = 0; nbi < 2; ++nbi)
#pragma unroll
            for (int tb = 0; tb < 4; ++tb) acc[nbi][tb] = mfma16(a[nbi], bq[tb], acc[nbi][tb]);
    }
#pragma unroll
    for (int nbi = 0; nbi < 2; ++nbi) { const int n = 32 * wave + 16 * nbi + 4 * g4; const f32x4 sc = *(const f32x4*)(pscale + 256 * gi + n);
#pragma unroll
        for (int tb = 0; tb < 4; ++tb) { const f32x4 o = acc[nbi][tb] * sc; u32x2 wv; wv.x = pk2(o[0], o[1]); wv.y = pk2(o[2], o[3]);
            *(u32x2*)(YCAT + (size_t)(row0 + 16 * tb + fr) * DM + DH + 256 * gi + n) = wv; } }
    __syncthreads();
}

#ifndef SCAN_U
#define SCAN_U 8
#endif
__device__ __forceinline__ void hgrn_scan(bf16_t* S, const float* DEC, int gtid, int gthreads) {
    for (int idx = gtid; idx < BATCH * NH * HD * HD / 4; idx += gthreads) {
        const int bh = idx >> 12, rem = idx & 4095, dk = rem >> 5;
        bf16_t* sp = S + (size_t)bh * NCH * (HD * HD) + rem * 4; const float* dp = DEC + (size_t)bh * NCH * HD + dk;
        f32x4 s = (f32x4){0.f, 0.f, 0.f, 0.f};
        for (int c0 = 0; c0 < NCH; c0 += SCAN_U) {
            u32x2 bw[SCAN_U]; float d[SCAN_U];
#pragma unroll
            for (int i = 0; i < SCAN_U; ++i) { bw[i] = *(const u32x2*)(sp + (size_t)(c0 + i) * (HD * HD)); d[i] = dp[(c0 + i) * HD]; }
#pragma unroll
            for (int i = 0; i < SCAN_U; ++i) { u32x2 o; o.x = pk2(s[0], s[1]); o.y = pk2(s[2], s[3]); *(u32x2*)(sp + (size_t)(c0 + i) * (HD * HD)) = o;
                s = s * d[i] + (f32x4){bflo(bw[i].x), bfhi(bw[i].x), bflo(bw[i].y), bfhi(bw[i].y)}; }
        }
    }
}

__device__ __forceinline__ void state_ld(const bf16_t* sg, u32x4 (&r)[4], int tid) {
#pragma unroll
    for (int it = 0; it < 4; ++it) { const int n = tid + NTHR * it, row = n >> 4, ch = n & 15; r[it] = *(const u32x4*)(sg + row * HD + ch * 8); }
}
__device__ __forceinline__ void hgrn_pass3_phase(LAS unsigned char* lds, int bx, int G, const bf16_t* Q, const bf16_t* Kk, const bf16_t* LF, const bf16_t* V, const bf16_t* Gt, const bf16_t* S,
                                                 const float* gnorm, bf16_t* YCAT, int tid) {
    LAS unsigned char* TQ = lds; LAS unsigned char* TK = lds + 16384; LAS unsigned char* TL = lds + 32768; LAS unsigned char* TV = lds + 49152; LAS unsigned char* TS = lds + 65536;
    LAS unsigned char* TA = lds + 98304; LAS float* PART = (LAS float*)(lds + 108544); LAS float* RED = (LAS float*)(lds + 112640); LAS unsigned char* TG = lds + 114688;
    const int dp = tid & 63, oct = tid >> 6;
    const unsigned lane = tid & 63, wave = tid >> 6, fr = lane & 15, g4 = lane >> 4;
    f32x4 gn[4];
#pragma unroll
    for (int cb = 0; cb < 4; ++cb) gn[cb] = *(const f32x4*)(gnorm + 16 * (4 * (wave >> 2) + cb) + 4 * g4);
    u32x4 rq[2], rk[2], rl[2], rv[2], rs[4], rg[2];
    if (bx < NUNIT) { const size_t go = unit_goff(bx); tile64_ld(Q + go, rq, tid); tile64_ld(Kk + go, rk, tid); tile64_ld(LF + go, rl, tid); tile64_ld(V + go, rv, tid); tile64_ld(Gt + go, rg, tid); state_ld(S + (size_t)bx * (HD * HD), rs, tid); }
    for (int unit = bx; unit < NUNIT; unit += G) {
        const int b = unit >> 10, h = (unit >> 7) & 7, c = unit & 127;
        const int row0 = b * SEQ + c * CH;
        tile64_st(rq, TQ, tid); tile64_st(rk, TK, tid); tile64_st(rl, TL, tid); tile64_st(rv, TV, tid); tile64_st(rg, TG, tid);
#pragma unroll
        for (int it = 0; it < 4; ++it) { const int n = tid + NTHR * it, row = n >> 4, ch = n & 15; *(LAS u32x4*)(TS + off_b(row, ch)) = rs[it]; }
        __syncthreads();
        if (unit + G < NUNIT) { const size_t go = unit_goff(unit + G); tile64_ld(Q + go, rq, tid); tile64_ld(Kk + go, rk, tid); tile64_ld(LF + go, rl, tid); tile64_ld(V + go, rv, tid); tile64_ld(Gt + go, rg, tid); state_ld(S + (size_t)(unit + G) * (HD * HD), rs, tid); }
        ScanOut sc; chunk_scan(TL, PART, dp, oct, sc);
#pragma unroll
        for (int i = 0; i < 8; ++i) { const unsigned o = off_b(8 * oct + i, dp >> 2) + 4 * (dp & 3);
            const unsigned qw = *(const LAS unsigned*)(TQ + o), kw = *(const LAS unsigned*)(TK + o);
            const float c0 = sc.pre0 + sc.cl[i][0], c1 = sc.pre1 + sc.cl[i][1];
            const float q0 = bflo(qw), q1 = bfhi(qw);
            *(LAS unsigned*)(TQ + o) = pk2(q0 * __expf(c0 - sc.mid0), q1 * __expf(c1 - sc.mid1));
            *(LAS unsigned*)(TK + o) = pk2(bflo(kw) * __expf(sc.mid0 - c0), bfhi(kw) * __expf(sc.mid1 - c1));
            *(LAS unsigned*)(TL + o) = pk2(q0 * __expf(c0), q1 * __expf(c1)); }
        __syncthreads();
        {
            const unsigned tb = wave >> 1;
#pragma unroll
            for (int sbi = 0; sbi < 2; ++sbi) { const unsigned sb = 2 * (wave & 1) + sbi; f32x4 a = (f32x4){0.f, 0.f, 0.f, 0.f};
#pragma unroll
                for (int ks = 0; ks < 4; ++ks) a = mfma16(tile_row(TK, lane, sb, ks), tile_row(TQ, lane, tb, ks), a);
                const int t = 16 * tb + fr, s0 = 16 * sb + 4 * g4;
                u32x2 w; w.x = pk2(s0 <= t ? a[0] : 0.f, s0 + 1 <= t ? a[1] : 0.f); w.y = pk2(s0 + 2 <= t ? a[2] : 0.f, s0 + 3 <= t ? a[3] : 0.f);
                *(LAS u32x2*)(TA + t * 144 + s0 * 2) = w; }
        }
        __syncthreads();
        const unsigned tb = wave & 3, dvh = wave >> 2;
        const int t = 16 * tb + fr;
        f32x4 acc[4];
#pragma unroll
        for (int cb = 0; cb < 4; ++cb) acc[cb] = (f32x4){0.f, 0.f, 0.f, 0.f};
#pragma unroll
        for (int ks = 0; ks < 2; ++ks) { const bf16x8 bq = *(const LAS bf16x8*)(TA + (16 * tb + fr) * 144 + 64 * ks + 16 * g4);
#pragma unroll
            for (int cb = 0; cb < 4; ++cb) acc[cb] = mfma16(tile_tr(TV, lane, 4 * dvh + cb, ks), bq, acc[cb]); }
#pragma unroll
        for (int ks = 0; ks < 4; ++ks) { const bf16x8 bq = tile_row(TL, lane, tb, ks);
#pragma unroll
            for (int cb = 0; cb < 4; ++cb) acc[cb] = mfma16(tile_tr(TS, lane, 4 * dvh + cb, ks), bq, acc[cb]); }
        float ss = 0.f;
#pragma unroll
        for (int cb = 0; cb < 4; ++cb) ss += (acc[cb][0] * acc[cb][0] + acc[cb][1] * acc[cb][1]) + (acc[cb][2] * acc[cb][2] + acc[cb][3] * acc[cb][3]);
        ss += __shfl_xor(ss, 16); ss += __shfl_xor(ss, 32);
        if (g4 == 0) RED[dvh * 64 + 16 * tb + fr] = ss;
        __syncthreads();
        const float r = rsqrtf((RED[16 * tb + fr] + RED[64 + 16 * tb + fr]) * (1.f / HD) + RMS_EPS);
#pragma unroll
        for (int cb = 0; cb < 4; ++cb) { const int dv = 16 * (4 * dvh + cb) + 4 * g4;
            const u32x2 gw = *(const LAS u32x2*)(TG + off_b(t, dv >> 3) + 2 * (dv & 7));
            const f32x4 sg = (f32x4){bflo(gw.x), bfhi(gw.x), bflo(gw.y), bfhi(gw.y)};
            const f32x4 o = acc[cb] * r * gn[cb] * sg; u32x2 wv; wv.x = pk2(o[0], o[1]); wv.y = pk2(o[2], o[3]);
            *(u32x2*)(YCAT + (size_t)(row0 + t) * DM + h * HD + dv) = wv; }
        __syncthreads();
    }
}
#define XB_TMO      128
#define XB_XCNT(j)  (256  + 64 * (j))
#define XB_XSUB(j)  (1280 + 64 * (j))
#define XB_XGEN(j)  (2304 + 64 * (j))
#define XB_TOP      3328
#define XB_TOPGEN   3392
#define XCD_BAR_WORDS 3456
#define XB_SPIN_CAP (1u << 18)

__device__ __forceinline__ unsigned xb_ld(unsigned* p)              { return __hip_atomic_load(p, __ATOMIC_RELAXED, __HIP_MEMORY_SCOPE_AGENT); }
__device__ __forceinline__ unsigned xb_add(unsigned* p, unsigned v) { return __hip_atomic_fetch_add(p, v, __ATOMIC_RELAXED, __HIP_MEMORY_SCOPE_AGENT); }
__device__ __forceinline__ unsigned xb_xcc_id() { return (unsigned)__builtin_amdgcn_s_getreg((3 << 11) | 20) & 0xFu; }
#define XB_SPIN(cond, bar) do { unsigned _sp = 0; while (cond) { __builtin_amdgcn_s_sleep(1); \
    if ((++_sp & 255u) == 0u) { if (xb_ld(&(bar)[XB_TMO])) break; if (_sp > XB_SPIN_CAP) { atomicAdd(&(bar)[XB_TMO], 1u); break; } } } } while (0)

struct XcdBarrier {
    unsigned* bar; unsigned x;
    volatile LAS unsigned* st;
};

__device__ __forceinline__ XcdBarrier xcd_barrier_post(unsigned* bar, volatile LAS unsigned* st) {
    XcdBarrier b; b.bar = bar; b.x = xb_xcc_id(); b.st = st;
    if (threadIdx.x == 0) (void)xb_add(&bar[XB_XCNT(b.x)], 1u);
    return b;
}
__device__ __forceinline__ void xcd_barrier_complete(unsigned* bar, unsigned x, unsigned& nloc, unsigned& nx) {
    const unsigned G = gridDim.x * gridDim.y * gridDim.z;
    unsigned sum, cnt, mine, sp = 0u;
    for (;;) {
        sum = 0u; cnt = 0u; mine = 0u;
#pragma unroll
        for (unsigned j = 0; j < 16; ++j) { const unsigned c = xb_ld(&bar[XB_XCNT(j)]); sum += c; cnt += (c > 0u) ? 1u : 0u; mine = (j == x) ? c : mine; }
        if (sum == G) break;
        __builtin_amdgcn_s_sleep(1);
        if ((++sp & 255u) == 0u) { if (xb_ld(&bar[XB_TMO])) break; if (sp > XB_SPIN_CAP) { atomicAdd(&bar[XB_TMO], 1u); break; } }
    }
    nloc = mine > 0u ? mine : 1u; nx = cnt > 0u ? cnt : 1u;
}

__device__ __forceinline__ void xcd_barrier(const XcdBarrier& b) {
    asm volatile("s_waitcnt vmcnt(0)" ::: "memory");
    __syncthreads();
    if (threadIdx.x == 0) {
        unsigned* bar = b.bar;
        __builtin_amdgcn_s_waitcnt(0);
        unsigned nloc = b.st[0], nx = b.st[1];
        if (nloc == 0u) { xcd_barrier_complete(bar, b.x, nloc, nx); b.st[0] = nloc; b.st[1] = nx; }
        const unsigned old = xb_add(&bar[XB_XSUB(b.x)], 1u);
        const unsigned gen = old / nloc;
        if (old + 1u == (gen + 1u) * nloc) {
            __builtin_amdgcn_fence(__ATOMIC_RELEASE, "agent");
            asm volatile("s_waitcnt vmcnt(0)" ::: "memory");
            const unsigned og = xb_add(&bar[XB_TOP], 1u);
            const unsigned tg = og / nx;
            if (og + 1u == (tg + 1u) * nx) xb_add(&bar[XB_TOPGEN], 1u);
            else XB_SPIN(xb_ld(&bar[XB_TOPGEN]) == tg, bar);
            __builtin_amdgcn_fence(__ATOMIC_ACQUIRE, "agent");
            xb_add(&bar[XB_XGEN(b.x)], 1u);
            asm volatile("s_waitcnt vmcnt(0)" ::: "memory");
        } else {
            XB_SPIN(xb_ld(&bar[XB_XGEN(b.x)]) == gen, bar);
            __builtin_amdgcn_fence(__ATOMIC_ACQUIRE, "agent");
            asm volatile("s_waitcnt vmcnt(0)" ::: "memory");
        }
    }
    __syncthreads();
}

#ifndef MK_N_LAUNCHES
#define MK_N_LAUNCHES 1
#endif
#ifndef WGM_GU
#define WGM_GU 4
#endif
#ifndef WGM_D
#define WGM_D 4
#endif
#ifndef WGM_IN
#define WGM_IN 4
#endif
#ifndef WGM_OUT
#define WGM_OUT 4
#endif
constexpr int N_PHASES = 13;
struct Params { const float* in[19]; float* out; unsigned char* ws; int ph_lo, ph_hi, li, pad; };
__global__ void __launch_bounds__(NTHR, 2) fwd_megakernel(Params p) {
    extern __shared__ __attribute__((aligned(16))) unsigned char lds_raw[];
    LAS unsigned char* lds = (LAS unsigned char*)lds_raw;
    cg::grid_group grid = cg::this_grid();
    const int tid = threadIdx.x, lane = tid & 63, wave = __builtin_amdgcn_readfirstlane(tid >> 6);
    const int G = gridDim.x, bx = blockIdx.x;
    const int gw = bx * NWAVES + wave, NGW = G * NWAVES;
    unsigned char* ws = p.ws;
    const float* x = p.in[0];
    bf16_t* Wgu1 = (bf16_t*)(ws + WS_WGU1); bf16_t* Wd1 = (bf16_t*)(ws + WS_WD1); bf16_t* Win = (bf16_t*)(ws + WS_WIN); bf16_t* Wout = (bf16_t*)(ws + WS_WOUT);
    bf16_t* Wpool = (bf16_t*)(ws + WS_WPOOL); bf16_t* Wgu2 = (bf16_t*)(ws + WS_WGU2); bf16_t* Wd2 = (bf16_t*)(ws + WS_WD2);
    bf16_t* Hb = (bf16_t*)(ws + WS_H); bf16_t* Yb = (bf16_t*)(ws + WS_Y); bf16_t* XN = (bf16_t*)(ws + WS_XN); bf16_t* YCAT = (bf16_t*)(ws + WS_YCAT);
    bf16_t* Qb = (bf16_t*)(ws + WS_Q); bf16_t* Kb = (bf16_t*)(ws + WS_K); bf16_t* LFb = (bf16_t*)(ws + WS_LF); bf16_t* Vb = (bf16_t*)(ws + WS_V); bf16_t* Gb = (bf16_t*)(ws + WS_G);
    bf16_t* Ub = (bf16_t*)(ws + WS_U); bf16_t* Sb = (bf16_t*)(ws + WS_S); float* DEC = (float*)(ws + WS_DEC); float* RS = (float*)(ws + WS_RS);
    const int lo = p.ph_lo, hi = p.ph_hi;
#define IN(k) (lo <= (k) && (k) < hi)
#define SEAM(k) do { if (IN(k) && IN((k) + 1)) xcd_barrier(bar); } while (0)
    volatile LAS unsigned* bst = (volatile LAS unsigned*)(lds + LDS_BYTES - 64);
    if (tid < 16) bst[tid] = 0u;
    __syncthreads();
    XcdBarrier bar; bar.bar = (unsigned*)ws + p.li * XCD_BAR_WORDS; bar.x = 0; bar.st = nullptr;
    if (hi - lo > 1) bar = xcd_barrier_post((unsigned*)ws + p.li * XCD_BAR_WORDS, bst);
    if (lo == -12345) grid.sync();

    if (IN(0)) {
        LAS float* scr = (LAS float*)(lds + wave * P0_SCR_BYTES);
        constexpr int I_GU = (DM / 64) * (FF / 64), I_D = (FF / 64) * (DM / 64), I_IN = (DM / 64) * (DIN / 64), I_OUT = (DM / 64) * (DM / 64), I_P = (256 / 64) * (256 / 64);
        static_assert(NWAVES * P0_SCR_BYTES <= LDS_BYTES - 64, "prologue scratch");
        constexpr int NITEMS = 4 * I_GU + 2 * I_D + I_IN + I_OUT + 4 * I_P;
        for (int it = gw; it < NITEMS; it += NGW) {
            int r = it;
            if (r < I_GU) { p0_matrix_item(p.in[2], DM, FF, Wgu1, 1, r, scr, lane, p.in[1]); continue; } r -= I_GU;
            if (r < I_GU) { p0_matrix_item(p.in[3], DM, FF, Wgu1, 2, r, scr, lane, p.in[1]); continue; } r -= I_GU;
            if (r < I_D) { p0_matrix_item(p.in[4], FF, DM, Wd1, 0, r, scr, lane); continue; } r -= I_D;
            if (r < I_IN) { p0_matrix_item(p.in[7], DM, DIN, Win, 0, r, scr, lane, p.in[6]); continue; } r -= I_IN;
            if (r < I_OUT) { p0_matrix_item(p.in[12], DM, DM, Wout, 0, r, scr, lane); continue; } r -= I_OUT;
            if (r < 4 * I_P) { const int gi = r / I_P; p0_matrix_item(p.in[10] + (size_t)gi * 65536, 256, 256, Wpool + (size_t)gi * 65536, 0, r % I_P, scr, lane); continue; } r -= 4 * I_P;
            if (r < I_GU) { p0_matrix_item(p.in[15], DM, FF, Wgu2, 1, r, scr, lane, p.in[14]); continue; } r -= I_GU;
            if (r < I_GU) { p0_matrix_item(p.in[16], DM, FF, Wgu2, 2, r, scr, lane, p.in[14]); continue; } r -= I_GU;
            p0_matrix_item(p.in[17], FF, DM, Wd2, 0, r, scr, lane);
        }
        rows_first(x, XN, RS, gw, NGW, lane);
        __syncthreads();
    }
    SEAM(0);
    if (IN(1)) { pg8::Gemm g{XN, Wgu1, M, 2 * FF, DM}; pg8::StaticOrder S; S.init(M, 2 * FF, G, bx, WGM_GU); pg8::EpiSwiglu E{Hb, FF, RS};
        pg8::gemm_phase<pg8::EpiSwiglu, pg8::StaticOrder, true, true>(lds, g, S, E); }
    SEAM(1);
    if (IN(2)) { pg8::Gemm g{Hb, Wd1, M, DM, FF}; pg8::StaticOrder S; S.init(M, DM, G, bx, WGM_D); pg8::EpiStore E{Yb, DM};
        pg8::gemm_phase<pg8::EpiStore, pg8::StaticOrder, true, true>(lds, g, S, E); }
    SEAM(2);
    if (IN(3)) rows_res<false>(x, Yb, 0.5f, p.in[5], XN, RS, nullptr, gw, NGW, lane);
    SEAM(3);
    if (IN(4)) { pg8::Gemm g{XN, Win, M, DIN, DM}; pg8::StaticOrder S; S.init(M, DIN, G, bx, WGM_IN); pg8::EpiWin E{Qb, Kb, LFb, Vb, Gb, Ub, p.in[8], RS};
        pg8::gemm_phase<pg8::EpiWin, pg8::StaticOrder, true, true>(lds, g, S, E); }
    SEAM(4);
    if (IN(5)) {
        hgrn_pass1_phase(lds, bx, G, Kb, LFb, Vb, Sb, DEC, tid);
        for (int u = bx; u < NPOOLU; u += G) pool_unit(lds, u, Ub, Wpool, p.in[11], YCAT, tid);
    }
    SEAM(5);
    if (IN(6)) hgrn_scan(Sb, DEC, bx * NTHR + tid, G * NTHR);
    SEAM(6);
    if (IN(7)) hgrn_pass3_phase(lds, bx, G, Qb, Kb, LFb, Vb, Gb, Sb, p.in[9], YCAT, tid);
    SEAM(7);
    if (IN(8)) { pg8::Gemm g{YCAT, Wout, M, DM, DM}; pg8::StaticOrder S; S.init(M, DM, G, bx, WGM_OUT); pg8::EpiStore E{Yb, DM};
        pg8::gemm_phase<pg8::EpiStore, pg8::StaticOrder, true, true>(lds, g, S, E); }
    SEAM(8);
    if (IN(9)) rows_res<false>(nullptr, Yb, 1.0f, p.in[13], XN, RS, nullptr, gw, NGW, lane);
    SEAM(9);
    if (IN(10)) { pg8::Gemm g{XN, Wgu2, M, 2 * FF, DM}; pg8::StaticOrder S; S.init(M, 2 * FF, G, bx, WGM_GU); pg8::EpiSwiglu E{Hb, FF, RS};
        pg8::gemm_phase<pg8::EpiSwiglu, pg8::StaticOrder, true, true>(lds, g, S, E); }
    SEAM(10);
    if (IN(11)) { pg8::Gemm g{Hb, Wd2, M, DM, FF}; pg8::StaticOrder S; S.init(M, DM, G, bx, WGM_D); pg8::EpiStore E{Yb, DM};
        pg8::gemm_phase<pg8::EpiStore, pg8::StaticOrder, true, true>(lds, g, S, E); }
    SEAM(11);
    if (IN(12)) rows_res<true>(nullptr, Yb, 0.5f, p.in[18], XN, nullptr, p.out, gw, NGW, lane);
#undef IN
#undef SEAM
}

extern "C" void kernel_launch(void* const* d_in, const int* in_sizes, int n_in, void* d_out, int out_size, void* d_ws, size_t ws_size, hipStream_t stream) {
    static int grid = 0;
    if (grid == 0) {
        if (n_in != 19 || in_sizes[0] != M * DM || out_size != M * DM || ws_size < WS_END) { fprintf(stderr, "kernel_launch: unexpected shapes (n_in %d in0 %d out %d ws %zu)\n", n_in, n_in > 0 ? in_sizes[0] : -1, out_size, ws_size); grid = -1; return; }
        int dev = 0, cus = 0, per_cu = 0;
        (void)hipGetDevice(&dev); (void)hipDeviceGetAttribute(&cus, hipDeviceAttributeMultiprocessorCount, dev);
        if (hipFuncSetAttribute((const void*)fwd_megakernel, hipFuncAttributeMaxDynamicSharedMemorySize, LDS_BYTES) != hipSuccess) { fprintf(stderr, "kernel_launch: hipFuncSetAttribute failed\n"); grid = -1; return; }
        if (hipOccupancyMaxActiveBlocksPerMultiprocessor(&per_cu, (const void*)fwd_megakernel, NTHR, LDS_BYTES) != hipSuccess || per_cu < 1) { fprintf(stderr, "kernel_launch: occupancy query says %d\n", per_cu); per_cu = 1; }
        (void)hipGetLastError();
        grid = cus * per_cu;
    }
    if (grid < 0) return;
    Params p{};
    for (int i = 0; i < 19; ++i) p.in[i] = (const float*)d_in[i];
    p.out = (float*)d_out; p.ws = (unsigned char*)d_ws;
#if MK_N_LAUNCHES == 1
    (void)hipMemsetAsync(d_ws, 0, 65536, stream);
    void* args[] = {&p};
#ifdef PROBE_PHASE
#ifndef PROBE_END
#define PROBE_END PROBE_PHASE
#endif
    p.ph_lo = 0; p.ph_hi = PROBE_END + 1;
    (void)hipLaunchCooperativeKernel((const void*)fwd_megakernel, dim3(grid), dim3(NTHR), args, LDS_BYTES, stream);
    p.ph_lo = PROBE_PHASE; p.ph_hi = PROBE_END + 1; p.li = 1;
    (void)hipLaunchCooperativeKernel((const void*)fwd_megakernel, dim3(grid), dim3(NTHR), args, LDS_BYTES, stream);
    p.ph_lo = PROBE_END + 1; p.ph_hi = N_PHASES; p.li = 2;
    (void)hipLaunchCooperativeKernel((const void*)fwd_megakernel, dim3(grid), dim3(NTHR), args, LDS_BYTES, stream);
#else
    p.ph_lo = 0; p.ph_hi = N_PHASES;
    hipError_t e = hipLaunchCooperativeKernel((const void*)fwd_megakernel, dim3(grid), dim3(NTHR), args, LDS_BYTES, stream);
    if (e != hipSuccess) fprintf(stderr, "cooperative launch failed: %s (grid %d)\n", hipGetErrorString(e), grid);
#endif
#else
    for (int ph = 0; ph < N_PHASES; ++ph) { p.ph_lo = ph; p.ph_hi = ph + 1; hipLaunchKernelGGL(fwd_megakernel, dim3(grid), dim3(NTHR), LDS_BYTES, stream, p); }
#endif
}
```

```cpp
#include <hip/hip_runtime.h>
#include <hip/hip_cooperative_groups.h>
#include <cstdio>
#include <cstdint>
namespace cg = cooperative_groups;
namespace pg8 {
#define PG8_LAS __attribute__((address_space(3)))
typedef unsigned short bf16_t;
typedef short bf16x8 __attribute__((ext_vector_type(8)));
typedef float f32x4 __attribute__((ext_vector_type(4)));
typedef unsigned u32x4 __attribute__((ext_vector_type(4)));
constexpr int BM = 256, BK = 64, HALF = 128, HTB = HALF * BK * 2  , STAGE_BYTES = 8 * HTB, NXCD = 8, WGM = 8;

__host__ __device__ __forceinline__ int lds_byte(int r, int c) { const int st = (r >> 4) * 2 + (c >> 5), rr = r & 15, cc = c & 31, ob = rr * 64 + cc * 2; return st * 1024 + (ob ^ (((ob >> 9) & 1) << 5)); }
__host__ __device__ __forceinline__ void stage_rc(int b, int& R, int& C) { const int st = b / 1024, sb = b % 1024, swz = sb ^ (((sb >> 9) & 1) << 5); R = (st >> 1) * 16 + swz / 64; C = (st & 1) * 32 + (swz % 64) / 2; }
__host__ __device__ __forceinline__ int perm32(int rho) { const int n = rho >> 4, i = rho & 15; return 8 * (i >> 2) + 4 * n + (i & 3); }

struct Unit { int pm, pn; };
struct Gemm { const bf16_t* A; const bf16_t* Bt; int M, N, K; };

struct StaticOrder {
    int nM, nN, nwg, G, c, wgm;
    __host__ __device__ void init(int M, int N, int G_, int c_, int wgm_ = WGM) { nM = M / BM; nN = N / BM; nwg = nM * nN; G = G_; c = c_; wgm = wgm_; }
    __host__ __device__ bool next(int i, Unit& u) const {
        const long L = (long)i * G + c; if (L >= nwg) return false;
        int wgid = (int)L; { const int q = nwg / NXCD, r = nwg % NXCD, xcd = wgid % NXCD, off = wgid / NXCD; wgid = (xcd < r ? xcd * (q + 1) : r * (q + 1) + (xcd - r) * q) + off; }
        const int nig = wgm * nN, gid = wgid / nig, fm = gid * wgm, gsz = (nM - fm) < wgm ? (nM - fm) : wgm;
        u.pm = fm + ((wgid % nig) % gsz); u.pn = (wgid % nig) / gsz; return true;
    }
    __device__ __forceinline__ void a_ready(const Unit&) const {}
    __device__ __forceinline__ void done(const Unit&) const {}
};

typedef __bf16 bf16v2_t __attribute__((ext_vector_type(2)));
typedef float f32x2 __attribute__((ext_vector_type(2)));
__device__ __forceinline__ unsigned cvt_pk_bf16(float lo, float hi) { const bf16v2_t v = __builtin_convertvector((f32x2){lo, hi}, bf16v2_t); return __builtin_bit_cast(unsigned, v); }
typedef unsigned u32x2 __attribute__((ext_vector_type(2)));
__device__ __forceinline__ float fast_sigmoid(float v) { return __builtin_amdgcn_rcpf(1.0f + __expf(-v)); }
__device__ __forceinline__ float silu_f(float v) { return v * fast_sigmoid(v); }
__device__ __forceinline__ void store8(bf16_t* p, const f32x4 v0, const f32x4 v1) {
    u32x4 w; w.x = cvt_pk_bf16(v0[0], v0[1]); w.y = cvt_pk_bf16(v0[2], v0[3]); w.z = cvt_pk_bf16(v1[0], v1[1]); w.w = cvt_pk_bf16(v1[2], v1[3]);
    *(u32x4*)p = w;
}
struct EpiStore {
    static constexpr bool PERM = true, AFTER_DRAIN = false;
    bf16_t* O; int ldc;
    struct Pre {};
    __device__ __forceinline__ void prefetch(Pre&, const Unit&, int, int) const {}
    __device__ __forceinline__ void operator()(const f32x4 (&acc)[2][2][4][2], const Unit& u, int wr, int wc, int fr, int fq, const Pre&) const {
        const int row0 = u.pm * BM + wr * 64 + fr, col0 = u.pn * BM + wc * 32 + 8 * fq;
#pragma unroll
        for (int ai = 0; ai < 2; ++ai)
#pragma unroll
            for (int m = 0; m < 4; ++m) { bf16_t* rowp = O + (size_t)(row0 + ai * HALF + m * 16) * ldc + col0;
#pragma unroll
                for (int bj = 0; bj < 2; ++bj) store8(rowp + bj * HALF, acc[ai][bj][m][0], acc[ai][bj][m][1]); }
    }
};
struct EpiSwiglu {
    static constexpr bool PERM = true, AFTER_DRAIN = false;
    bf16_t* O; int ldc; const float* rs;
    struct Pre { float r[2][4]; };
    __device__ __forceinline__ void prefetch(Pre& p, const Unit& u, int wr, int fr) const {
#pragma unroll
        for (int ai = 0; ai < 2; ++ai)
#pragma unroll
            for (int m = 0; m < 4; ++m) p.r[ai][m] = rs[u.pm * BM + wr * 64 + fr + ai * HALF + m * 16];
    }
    __device__ __forceinline__ void operator()(const f32x4 (&acc)[2][2][4][2], const Unit& u, int wr, int wc, int fr, int fq, const Pre& pre) const {
        const int row0 = u.pm * BM + wr * 64 + fr, col0 = u.pn * HALF + wc * 32 + 8 * fq;
#pragma unroll
        for (int ai = 0; ai < 2; ++ai)
#pragma unroll
            for (int m = 0; m < 4; ++m) { bf16_t* rowp = O + (size_t)(row0 + ai * HALF + m * 16) * ldc + col0;
                f32x4 h0, h1; const float r = pre.r[ai][m];
#pragma unroll
                for (int j = 0; j < 4; ++j) { h0[j] = silu_f(r * acc[ai][0][m][0][j]) * (r * acc[ai][1][m][0][j]); h1[j] = silu_f(r * acc[ai][0][m][1][j]) * (r * acc[ai][1][m][1][j]); }
                store8(rowp, h0, h1); }
    }
};
struct EpiWin {
    static constexpr bool PERM = true, AFTER_DRAIN = false;
    bf16_t *Q, *Kk, *LF, *V, *G, *U; const float* lbl; const float* rs;
    struct Pre { float r[2][4]; };
    __device__ __forceinline__ void prefetch(Pre& p, const Unit& u, int wr, int fr) const {
#pragma unroll
        for (int ai = 0; ai < 2; ++ai)
#pragma unroll
            for (int m = 0; m < 4; ++m) p.r[ai][m] = rs[u.pm * BM + wr * 64 + fr + ai * HALF + m * 16];
    }
    __device__ __forceinline__ void operator()(const f32x4 (&acc)[2][2][4][2], const Unit& u, int wr, int wc, int fr, int fq, const Pre& pre) const {
        const int seg = u.pn >> 2, colt = (u.pn & 3) * BM;
        const int row0 = u.pm * BM + wr * 64 + fr, col0 = colt + wc * 32 + 8 * fq;
        if (seg == 1) {
            f32x4 lb[2][2], om[2][2];
#pragma unroll
            for (int bj = 0; bj < 2; ++bj)
#pragma unroll
                for (int n = 0; n < 2; ++n) { const f32x4 a0 = *(const f32x4*)(lbl + col0 + bj * HALF + 4 * n), a1 = *(const f32x4*)(lbl + 1024 + col0 + bj * HALF + 4 * n);
#pragma unroll
                    for (int j = 0; j < 4; ++j) { const float l = 1.0f / (1.0f + __expf(a1[j] - a0[j])); lb[bj][n][j] = l; om[bj][n][j] = 1.0f - l; } }
#pragma unroll
            for (int ai = 0; ai < 2; ++ai)
#pragma unroll
                for (int m = 0; m < 4; ++m) { const size_t ro = (size_t)(row0 + ai * HALF + m * 16) * 1024 + col0; const float r = pre.r[ai][m];
#pragma unroll
                    for (int bj = 0; bj < 2; ++bj) { f32x4 k0, k1, l0, l1;
#pragma unroll
                        for (int j = 0; j < 4; ++j) {
                            const float z0 = r * acc[ai][bj][m][0][j], z1 = r * acc[ai][bj][m][1][j];
                            const float s0 = fast_sigmoid(z0), s1 = fast_sigmoid(z1);
                            const float f0 = lb[bj][0][j] + om[bj][0][j] * s0, f1 = lb[bj][1][j] + om[bj][1][j] * s1;
                            k0[j] = om[bj][0][j] * (1.0f - s0); k1[j] = om[bj][1][j] * (1.0f - s1);
                            l0[j] = __logf(f0); l1[j] = __logf(f1); }
                        store8(Kk + ro + bj * HALF, k0, k1); store8(LF + ro + bj * HALF, l0, l1); } }
        } else {
            bf16_t* O = seg == 0 ? Q : (seg == 2 ? V : (seg == 3 ? G : U));
#pragma unroll
            for (int ai = 0; ai < 2; ++ai)
#pragma unroll
                for (int m = 0; m < 4; ++m) { bf16_t* rowp = O + (size_t)(row0 + ai * HALF + m * 16) * 1024 + col0; const float r = pre.r[ai][m];
#pragma unroll
                    for (int bj = 0; bj < 2; ++bj) { f32x4 v0 = acc[ai][bj][m][0] * r, v1 = acc[ai][bj][m][1] * r;
                        if (seg == 3) {
#pragma unroll
                            for (int j = 0; j < 4; ++j) { v0[j] = silu_f(v0[j]); v1[j] = silu_f(v1[j]); } }
                        store8(rowp + bj * HALF, v0, v1); } }
        }
    }
};

template <class Epi, class Sched, bool ALIGN_EPI = false, bool SP2 = false>
__device__ __forceinline__ void gemm_phase(PG8_LAS unsigned char* lds, const Gemm g, const Sched& S, const Epi& E) {
    const int tid = threadIdx.x, wid = __builtin_amdgcn_readfirstlane(tid >> 6), lane = tid & 63, wr = wid >> 2, wc = wid & 3, fr = lane & 15, fq = lane >> 4;
    const int K = g.K, nt = K / BK;
    unsigned voffA[2], voffB[2];
#pragma unroll
    for (int i = 0; i < 2; ++i) { int R, C; stage_rc(tid * 16 + i * 8192, R, C); const int Rb = Epi::PERM ? ((R & ~31) + perm32(R & 31)) : R;
        voffA[i] = (unsigned)(R * K + C) * 2u; voffB[i] = (unsigned)(Rb * K + C) * 2u; }
    const size_t kstep = (size_t)(BK * 2);
    const size_t hstep = (size_t)HALF * K * 2;
    const size_t tstep = 2 * hstep;
    const unsigned ldsw = (unsigned)wid * 1024u;
    const int aoff = lds_byte(wr * 64 + fr, fq * 8), boff = lds_byte(wc * 32 + fr, fq * 8);
#define PG8_SA(b, h) (((b) * 2 + (h)) * HTB)
#define PG8_SB(b, h) ((4 + (b) * 2 + (h)) * HTB)
#define PG8_STAGE(bufoff, gbase, voff) do { _Pragma("unroll") for (int _i = 0; _i < 2; ++_i) \
        __builtin_amdgcn_global_load_lds((const unsigned*)((const char*)(gbase) + (voff)[_i]), (PG8_LAS unsigned*)(lds + (bufoff) + ldsw + _i * 8192), 16, 0, 0); } while (0)
#define PG8_LDA(dst, b, h) do { _Pragma("unroll") for (int m = 0; m < 4; ++m) _Pragma("unroll") for (int k = 0; k < 2; ++k) dst[m][k] = *(const PG8_LAS bf16x8*)(lds + PG8_SA(b, h) + aoff + m * 2048 + k * 1024); } while (0)
#define PG8_LDB(dst, b, h) do { _Pragma("unroll") for (int n = 0; n < 2; ++n) _Pragma("unroll") for (int k = 0; k < 2; ++k) dst[n][k] = *(const PG8_LAS bf16x8*)(lds + PG8_SB(b, h) + boff + n * 2048 + k * 1024); } while (0)
#define PG8_MF1(ai, bj, At, Bt, m, n, k) do { acc[ai][bj][m][n] = __builtin_amdgcn_mfma_f32_16x16x32_bf16(Bt[n][k], At[m][k], acc[ai][bj][m][n], 0, 0, 0); __builtin_amdgcn_sched_barrier(0); } while (0)
#define PG8_MMA(ai, bj, At, Bt) do { __builtin_amdgcn_s_setprio(1); __builtin_amdgcn_sched_barrier(0); \
        PG8_MF1(ai, bj, At, Bt, 0, 0, 0); PG8_MF1(ai, bj, At, Bt, 0, 1, 0); PG8_MF1(ai, bj, At, Bt, 1, 1, 0); PG8_MF1(ai, bj, At, Bt, 1, 0, 0); \
        PG8_MF1(ai, bj, At, Bt, 2, 0, 0); PG8_MF1(ai, bj, At, Bt, 2, 1, 0); PG8_MF1(ai, bj, At, Bt, 3, 1, 0); PG8_MF1(ai, bj, At, Bt, 3, 0, 0); \
        PG8_MF1(ai, bj, At, Bt, 0, 0, 1); PG8_MF1(ai, bj, At, Bt, 0, 1, 1); PG8_MF1(ai, bj, At, Bt, 1, 1, 1); PG8_MF1(ai, bj, At, Bt, 1, 0, 1); \
        PG8_MF1(ai, bj, At, Bt, 2, 0, 1); PG8_MF1(ai, bj, At, Bt, 2, 1, 1); PG8_MF1(ai, bj, At, Bt, 3, 1, 1); PG8_MF1(ai, bj, At, Bt, 3, 0, 1); \
        __builtin_amdgcn_s_setprio(0); } while (0)
#define PG8_WAIT_V(n) asm volatile("s_waitcnt vmcnt(" #n ")" ::: "memory")
#define PG8_WAIT_L(n) asm volatile("s_waitcnt lgkmcnt(" #n ")" ::: "memory")
#define PG8_BAR __builtin_amdgcn_s_barrier()
#define PG8_SCHED __builtin_amdgcn_sched_barrier(0)
    Unit cur, nxt; int ui = 0;
    if (!S.next(0, cur)) return;
    f32x4 acc[2][2][4][2];
#pragma unroll
    for (int a = 0; a < 2; ++a)
#pragma unroll
        for (int b = 0; b < 2; ++b)
#pragma unroll
            for (int m = 0; m < 4; ++m)
#pragma unroll
                for (int n = 0; n < 2; ++n) acc[a][b][m][n] = (f32x4){0.f, 0.f, 0.f, 0.f};
    bf16x8 At[4][2], B0[2][2], B1[2][2];
    const char* cA = (const char*)g.A + (size_t)cur.pm * tstep; const char* cB = (const char*)g.Bt + (size_t)cur.pn * tstep;
    S.a_ready(cur);
    typename Epi::Pre pre; E.prefetch(pre, cur, wr, fr);
    if constexpr (SP2) {
        PG8_STAGE(PG8_SB(0, 0), cB, voffB); PG8_STAGE(PG8_SB(0, 1), cB + hstep, voffB); PG8_STAGE(PG8_SA(0, 0), cA, voffA); PG8_STAGE(PG8_SA(0, 1), cA + hstep, voffA);
        if (wr == 1) PG8_BAR;
        PG8_WAIT_V(2); PG8_BAR;
        PG8_STAGE(PG8_SB(1, 0), cB + kstep, voffB); PG8_STAGE(PG8_SA(1, 0), cA + kstep, voffA); PG8_STAGE(PG8_SB(1, 1), cB + hstep + kstep, voffB);
        PG8_WAIT_V(6); PG8_BAR;
    } else {
        PG8_STAGE(PG8_SB(0, 0), cB, voffB); PG8_STAGE(PG8_SA(0, 0), cA, voffA); PG8_STAGE(PG8_SB(0, 1), cB + hstep, voffB); PG8_STAGE(PG8_SA(0, 1), cA + hstep, voffA);
        if (wr == 1) PG8_BAR;
        PG8_WAIT_V(4); PG8_BAR;
        PG8_STAGE(PG8_SB(1, 0), cB + kstep, voffB); PG8_STAGE(PG8_SA(1, 0), cA + kstep, voffA); PG8_STAGE(PG8_SB(1, 1), cB + hstep + kstep, voffB);
        PG8_WAIT_V(6); PG8_BAR;
    }
    for (;;) {
        const bool has_next = S.next(ui + 1, nxt);
        const char* nA = has_next ? (const char*)g.A + (size_t)nxt.pm * tstep : cA; const char* nB = has_next ? (const char*)g.Bt + (size_t)nxt.pn * tstep : cB;
        for (int t = 0; t < nt; t += 2) {
            const bool last = (t == nt - 2);
            const char* a1 = cA + (size_t)(t + 1) * kstep;
            const char* a2 = last ? nA : cA + (size_t)(t + 2) * kstep; const char* b2 = last ? nB : cB + (size_t)(t + 2) * kstep;
            const char* a3 = a2 + kstep; const char* b3 = b2 + kstep;
            if (last && has_next) S.a_ready(nxt);
            if constexpr (SP2) {
            PG8_LDB(B0, 0, 0); PG8_LDB(B1, 0, 1); PG8_SCHED; PG8_LDA(At, 0, 0); PG8_STAGE(PG8_SA(1, 1), a1 + hstep, voffA);
            PG8_WAIT_V(8); PG8_WAIT_L(0); PG8_BAR; PG8_MMA(0, 0, At, B0); PG8_MMA(0, 1, At, B1); PG8_BAR; PG8_SCHED;
            PG8_LDA(At, 0, 1); PG8_STAGE(PG8_SB(0, 0), b2, voffB); PG8_STAGE(PG8_SB(0, 1), b2 + hstep, voffB); PG8_STAGE(PG8_SA(0, 0), a2, voffA);
            PG8_WAIT_V(8); PG8_WAIT_L(0); PG8_BAR; PG8_MMA(1, 0, At, B0); PG8_MMA(1, 1, At, B1); PG8_BAR; PG8_SCHED;
            PG8_LDB(B0, 1, 0); PG8_LDB(B1, 1, 1); PG8_SCHED; PG8_LDA(At, 1, 0); PG8_STAGE(PG8_SA(0, 1), a2 + hstep, voffA);
            PG8_WAIT_V(8); PG8_WAIT_L(0); PG8_BAR; PG8_MMA(0, 0, At, B0); PG8_MMA(0, 1, At, B1); PG8_BAR; PG8_SCHED;
            PG8_LDA(At, 1, 1); PG8_STAGE(PG8_SB(1, 0), b3, voffB); PG8_STAGE(PG8_SB(1, 1), b3 + hstep, voffB); PG8_STAGE(PG8_SA(1, 0), a3, voffA);
            PG8_WAIT_V(8); PG8_WAIT_L(0); PG8_BAR; PG8_MMA(1, 0, At, B0); PG8_MMA(1, 1, At, B1); PG8_BAR; PG8_SCHED;
            } else {
            PG8_LDB(B0, 0, 0); PG8_SCHED; PG8_LDA(At, 0, 0); PG8_STAGE(PG8_SA(1, 1), a1 + hstep, voffA);
            PG8_WAIT_L(8); PG8_BAR; PG8_WAIT_L(0); PG8_MMA(0, 0, At, B0); PG8_BAR; PG8_SCHED;
            PG8_LDB(B1, 0, 1); PG8_STAGE(PG8_SB(0, 0), b2, voffB);
            PG8_BAR; PG8_WAIT_L(0); PG8_MMA(0, 1, At, B1); PG8_BAR;
            PG8_LDA(At, 0, 1); PG8_STAGE(PG8_SA(0, 0), a2, voffA);
            PG8_BAR; PG8_WAIT_L(0); PG8_MMA(1, 0, At, B0); PG8_BAR; PG8_SCHED;
            PG8_STAGE(PG8_SB(0, 1), b2 + hstep, voffB);
            PG8_WAIT_V(6); PG8_BAR; PG8_MMA(1, 1, At, B1); PG8_BAR;
            PG8_LDB(B0, 1, 0); PG8_SCHED; PG8_LDA(At, 1, 0); PG8_STAGE(PG8_SA(0, 1), a2 + hstep, voffA);
            PG8_WAIT_L(8); PG8_BAR; PG8_WAIT_L(0); PG8_MMA(0, 0, At, B0); PG8_BAR; PG8_SCHED;
            PG8_LDB(B1, 1, 1); PG8_STAGE(PG8_SB(1, 0), b3, voffB);
            PG8_BAR; PG8_WAIT_L(0); PG8_MMA(0, 1, At, B1); PG8_BAR;
            PG8_LDA(At, 1, 1); PG8_STAGE(PG8_SA(1, 0), a3, voffA);
            PG8_BAR; PG8_WAIT_L(0); PG8_MMA(1, 0, At, B0); PG8_BAR; PG8_SCHED;
            PG8_STAGE(PG8_SB(1, 1), b3 + hstep, voffB);
            PG8_WAIT_V(6); PG8_BAR; PG8_MMA(1, 1, At, B1); PG8_BAR;
            }
        }
        if constexpr (ALIGN_EPI) { if (wr == 0) PG8_BAR; }
        if constexpr (!Epi::AFTER_DRAIN) { E(acc, cur, wr, wc, fr, fq, pre); S.done(cur); }
        if (!has_next) break;
#pragma unroll
        for (int a = 0; a < 2; ++a)
#pragma unroll
            for (int b = 0; b < 2; ++b)
#pragma unroll
                for (int m = 0; m < 4; ++m)
#pragma unroll
                    for (int n = 0; n < 2; ++n) acc[a][b][m][n] = (f32x4){0.f, 0.f, 0.f, 0.f};
        cur = nxt; cA = nA; cB = nB; ++ui;
        E.prefetch(pre, cur, wr, fr);
        if constexpr (ALIGN_EPI) { if (wr == 1) PG8_BAR; }
    }
    PG8_WAIT_V(0);
    if constexpr (!ALIGN_EPI) { if (wr == 0) PG8_BAR; }
    PG8_BAR;
#undef PG8_SA
#undef PG8_SB
#undef PG8_STAGE
#undef PG8_LDA
#undef PG8_LDB
#undef PG8_MMA
#undef PG8_MF1
#undef PG8_WAIT_V
#undef PG8_WAIT_L
#undef PG8_BAR
#undef PG8_SCHED
}
}
using pg8::bf16_t; using pg8::bf16x8; using pg8::f32x4; using pg8::u32x4; using pg8::f32x2; using pg8::u32x2;
#define LAS __attribute__((address_space(3)))
constexpr int NWAVES = 8, NTHR = NWAVES * 64;
constexpr int BATCH = 4, SEQ = 8192, DM = 2048, M = BATCH * SEQ, FF = 5632, DH = 1024, HD = 128, NH = 8, DP = 1024, DIN = 5120;
constexpr int CH = 64, NCH = SEQ / CH, NUNIT = BATCH * NH * NCH;
constexpr int NPOOLU = (M / 64) * 4;
constexpr float RMS_EPS = 1e-6f;
constexpr size_t MiB = 1u << 20;
constexpr size_t WS_WGU1 = 1 * MiB, WS_WD1 = 45 * MiB, WS_WIN = 67 * MiB, WS_WOUT = 87 * MiB, WS_WPOOL = 95 * MiB, WS_WGU2 = 96 * MiB, WS_WD2 = 140 * MiB;
constexpr size_t WS_H = 162 * MiB;
constexpr size_t WS_Q = 162 * MiB, WS_K = 226 * MiB, WS_LF = 290 * MiB, WS_V = 354 * MiB, WS_G = 418 * MiB;
constexpr size_t WS_Y = 514 * MiB;
constexpr size_t WS_S = WS_Y;
constexpr size_t WS_XN = 642 * MiB;
constexpr size_t WS_YCAT = 770 * MiB;
constexpr size_t WS_U = 898 * MiB;
constexpr size_t WS_DEC = 962 * MiB;
constexpr size_t WS_RS = 964 * MiB;
constexpr size_t WS_END = 965 * MiB;
constexpr int LDS_BYTES = 147456;

__device__ __forceinline__ float bf2f(unsigned short b) { return __builtin_bit_cast(float, (unsigned)b << 16); }
__device__ __forceinline__ float bflo(unsigned w) { return __builtin_bit_cast(float, w << 16); }
__device__ __forceinline__ float bfhi(unsigned w) { return __builtin_bit_cast(float, w & 0xffff0000u); }
__device__ __forceinline__ unsigned pk2(float lo, float hi) { return pg8::cvt_pk_bf16(lo, hi); }
__device__ __forceinline__ float wave_sum(float v) {
#pragma unroll
    for (int o = 1; o < 64; o <<= 1) v += __shfl_xor(v, o);
    return v;
}
#define LDS_WAIT() asm volatile("s_waitcnt lgkmcnt(0)" ::: "memory")

constexpr int P0_PITCH = 68, P0_SCR_BYTES = 64 * P0_PITCH * 4;
__device__ __forceinline__ void p0_transpose_item(const float* W, int K, int N, bf16_t* WT, int k0, int n0, int drow0, LAS float* scr, int lane, const float* gk) {
    const int lr = lane >> 4, lc = lane & 15;
    f32x4 v[16];
#pragma unroll
    for (int i = 0; i < 16; ++i) v[i] = *(const f32x4*)(W + (size_t)(k0 + 4 * i + lr) * N + n0 + 4 * lc);
#pragma unroll
    for (int i = 0; i < 16; ++i) { const float gsc = gk ? gk[k0 + 4 * i + lr] : 1.0f; *(LAS f32x4*)(scr + (4 * i + lr) * P0_PITCH + 4 * lc) = v[i] * gsc; }
    LDS_WAIT(); asm volatile("" ::: "memory");
    const int c = lane & 7;
#pragma unroll
    for (int j = 0; j < 8; ++j) { const int n = (lane >> 3) + 8 * j; const LAS float* s = scr + (8 * c) * P0_PITCH + n;
        u32x4 o; o.x = pk2(s[0 * P0_PITCH], s[1 * P0_PITCH]); o.y = pk2(s[2 * P0_PITCH], s[3 * P0_PITCH]); o.z = pk2(s[4 * P0_PITCH], s[5 * P0_PITCH]); o.w = pk2(s[6 * P0_PITCH], s[7 * P0_PITCH]);
        *(u32x4*)(WT + (size_t)(drow0 + n) * K + k0 + 8 * c) = o; }
    LDS_WAIT(); asm volatile("" ::: "memory");
}
__device__ __forceinline__ void p0_matrix_item(const float* W, int K, int N, bf16_t* WT, int mode, int item, LAS float* scr, int lane, const float* gk = nullptr) {
    const int nblk = N / 64, kb = item / nblk, nb = item % nblk, n0 = 64 * nb;
    const int drow0 = mode == 0 ? n0 : (256 * (n0 >> 7) + (n0 & 127) + (mode == 2 ? 128 : 0));
    p0_transpose_item(W, K, N, WT, 64 * kb, n0, drow0, scr, lane, gk);
}

__device__ __forceinline__ void rows_first(const float* __restrict__ x, bf16_t* __restrict__ XB, float* __restrict__ RS, int gw, int NGW, int lane) {
    for (int m0 = gw; m0 < M; m0 += 2 * NGW) {
        const int m1 = (m0 + NGW < M) ? m0 + NGW : m0;
        f32x4 v[2][8]; float s[2] = {0.f, 0.f};
#pragma unroll
        for (int q = 0; q < 2; ++q) { const f32x4* xr = (const f32x4*)(x + (size_t)(q ? m1 : m0) * DM) + lane;
#pragma unroll
            for (int j = 0; j < 8; ++j) v[q][j] = xr[64 * j]; }
#pragma unroll
        for (int q = 0; q < 2; ++q) {
#pragma unroll
            for (int j = 0; j < 8; ++j) s[q] += (v[q][j].x * v[q][j].x + v[q][j].y * v[q][j].y) + (v[q][j].z * v[q][j].z + v[q][j].w * v[q][j].w);
            u32x2* o = (u32x2*)(XB + (size_t)(q ? m1 : m0) * DM) + lane;
#pragma unroll
            for (int j = 0; j < 8; ++j) { u32x2 w; w.x = pk2(v[q][j].x, v[q][j].y); w.y = pk2(v[q][j].z, v[q][j].w); o[64 * j] = w; } }
        const float r0 = rsqrtf(wave_sum(s[0]) * (1.f / DM) + RMS_EPS), r1 = rsqrtf(wave_sum(s[1]) * (1.f / DM) + RMS_EPS);
        if (lane == 0) { RS[m0] = r0; RS[m1] = r1; }
    }
}
template <bool FINAL>
__device__ __forceinline__ void rows_res(const float* xf, const bf16_t* Y, float coef, const float* g1, bf16_t* XB, float* RS, float* out, int gw, int NGW, int lane) {
    for (int m = gw; m < M; m += NGW) {
        const u32x2* yr = (const u32x2*)(Y + (size_t)m * DM) + lane;
        f32x4 v[8], y[8]; float s = 0.f;
        if (xf) { const f32x4* xr = (const f32x4*)(xf + (size_t)m * DM) + lane;
#pragma unroll
            for (int j = 0; j < 8; ++j) v[j] = xr[64 * j];
        } else { const u32x2* xr = (const u32x2*)(XB + (size_t)m * DM) + lane;
#pragma unroll
            for (int j = 0; j < 8; ++j) { const u32x2 w = xr[64 * j]; v[j] = (f32x4){bflo(w.x), bfhi(w.x), bflo(w.y), bfhi(w.y)}; } }
#pragma unroll
        for (int j = 0; j < 8; ++j) { const u32x2 w = yr[64 * j]; y[j] = (f32x4){bflo(w.x), bfhi(w.x), bflo(w.y), bfhi(w.y)};
            s += (y[j].x * y[j].x + y[j].y * y[j].y) + (y[j].z * y[j].z + y[j].w * y[j].w); }
        const float r1 = coef * rsqrtf(wave_sum(s) * (1.f / DM) + RMS_EPS);
        float s2 = 0.f;
#pragma unroll
        for (int j = 0; j < 8; ++j) { const f32x4 gg = *((const f32x4*)g1 + lane + 64 * j); v[j] = v[j] + y[j] * r1 * gg;
            s2 += (v[j].x * v[j].x + v[j].y * v[j].y) + (v[j].z * v[j].z + v[j].w * v[j].w); }
        if (FINAL) { f32x4* xw = (f32x4*)(out + (size_t)m * DM) + lane;
#pragma unroll
            for (int j = 0; j < 8; ++j) xw[64 * j] = v[j];
        } else {
            u32x2* o = (u32x2*)(XB + (size_t)m * DM) + lane;
#pragma unroll
            for (int j = 0; j < 8; ++j) { u32x2 w; w.x = pk2(v[j].x, v[j].y); w.y = pk2(v[j].z, v[j].w); o[64 * j] = w; }
            const float r2 = rsqrtf(wave_sum(s2) * (1.f / DM) + RMS_EPS);
            if (lane == 0) RS[m] = r2;
        }
    }
}

__device__ __forceinline__ unsigned off_b(unsigned row, unsigned ch) { return 256u * row + 16u * (ch ^ (((row & 3u) << 2) | ((row >> 2) & 3u))); }
__device__ __forceinline__ unsigned row_addr16(unsigned lane, unsigned rb, unsigned s) { return off_b((lane & 15) + 16 * rb, 4 * s + (lane >> 4)); }
__device__ __forceinline__ unsigned tr_addr16(unsigned lane, unsigned c, unsigned ks, unsigned t) { const unsigned g = lane >> 4, q = (lane & 15) >> 2, p = lane & 3; return off_b(32 * ks + 8 * g + 4 * t + q, 2 * c + (p >> 1)) + 8 * (p & 1); }
typedef short s16x4 __attribute__((ext_vector_type(4)));
__device__ __forceinline__ bf16x8 tile_tr(LAS unsigned char* tile, unsigned lane, unsigned c, unsigned ks) {
    const s16x4 lo = __builtin_amdgcn_ds_read_tr16_b64_v4i16((LAS s16x4*)(tile + tr_addr16(lane, c, ks, 0)));
    const s16x4 hi = __builtin_amdgcn_ds_read_tr16_b64_v4i16((LAS s16x4*)(tile + tr_addr16(lane, c, ks, 1)));
    return (bf16x8){lo[0], lo[1], lo[2], lo[3], hi[0], hi[1], hi[2], hi[3]};
}
__device__ __forceinline__ bf16x8 tile_row(LAS unsigned char* tile, unsigned lane, unsigned rb, unsigned s) { return *(const LAS bf16x8*)(tile + row_addr16(lane, rb, s)); }
__device__ __forceinline__ f32x4 mfma16(bf16x8 a, bf16x8 b, f32x4 c) { return __builtin_amdgcn_mfma_f32_16x16x32_bf16(a, b, c, 0, 0, 0); }

__device__ __forceinline__ void tile64_ld(const bf16_t* g, u32x4 (&r)[2], int tid) {
#pragma unroll
    for (int it = 0; it < 2; ++it) { const int n = tid + NTHR * it, row = n >> 4, ch = n & 15; r[it] = *(const u32x4*)(g + (size_t)row * 1024 + ch * 8); }
}
__device__ __forceinline__ void tile64_st(const u32x4 (&r)[2], LAS unsigned char* tile, int tid) {
#pragma unroll
    for (int it = 0; it < 2; ++it) { const int n = tid + NTHR * it, row = n >> 4, ch = n & 15; *(LAS u32x4*)(tile + off_b(row, ch)) = r[it]; }
}
struct ScanOut { float cl[8][2]; float pre0, pre1, tot0, tot1, mid0, mid1; };
__device__ __forceinline__ void chunk_scan(LAS unsigned char* TL, LAS float* PART, int dp, int oct, ScanOut& o) {
    float r0 = 0.f, r1 = 0.f;
#pragma unroll
    for (int i = 0; i < 8; ++i) { const unsigned w = *(const LAS unsigned*)(TL + off_b(8 * oct + i, dp >> 2) + 4 * (dp & 3)); r0 += bflo(w); r1 += bfhi(w); o.cl[i][0] = r0; o.cl[i][1] = r1; }
    *(LAS f32x2*)(PART + oct * 128 + 2 * dp) = (f32x2){r0, r1};
    __syncthreads();
    o.pre0 = o.pre1 = o.tot0 = o.tot1 = o.mid0 = o.mid1 = 0.f;
#pragma unroll
    for (int q = 0; q < 8; ++q) { const f32x2 p = *(const LAS f32x2*)(PART + q * 128 + 2 * dp); if (q < oct) { o.pre0 += p.x; o.pre1 += p.y; } if (q < 4) { o.mid0 += p.x; o.mid1 += p.y; } o.tot0 += p.x; o.tot1 += p.y; }
}

__device__ __forceinline__ size_t unit_goff(int unit) { const int b = unit >> 10, h = (unit >> 7) & 7, c = unit & 127; return (size_t)(b * SEQ + c * CH) * 1024 + h * HD; }
__device__ __forceinline__ void hgrn_pass1_phase(LAS unsigned char* lds, int bx, int G, const bf16_t* Kk, const bf16_t* LF, const bf16_t* V, bf16_t* S, float* DEC, int tid) {
    LAS unsigned char* TK = lds; LAS unsigned char* TL = lds + 16384; LAS unsigned char* TV = lds + 32768; LAS float* PART = (LAS float*)(lds + 49152);
    const int dp = tid & 63, oct = tid >> 6;
    const unsigned lane = tid & 63, wave = tid >> 6, fr = lane & 15, g4 = lane >> 4;
    u32x4 rk[2], rl[2], rv[2];
    if (bx < NUNIT) { const size_t go = unit_goff(bx); tile64_ld(Kk + go, rk, tid); tile64_ld(LF + go, rl, tid); tile64_ld(V + go, rv, tid); }
    for (int unit = bx; unit < NUNIT; unit += G) {
        tile64_st(rk, TK, tid); tile64_st(rl, TL, tid); tile64_st(rv, TV, tid);
        __syncthreads();
        if (unit + G < NUNIT) { const size_t go = unit_goff(unit + G); tile64_ld(Kk + go, rk, tid); tile64_ld(LF + go, rl, tid); tile64_ld(V + go, rv, tid); }
        ScanOut sc; chunk_scan(TL, PART, dp, oct, sc);
#pragma unroll
        for (int i = 0; i < 8; ++i) { LAS unsigned* p = (LAS unsigned*)(TK + off_b(8 * oct + i, dp >> 2) + 4 * (dp & 3)); const unsigned w = *p;
            const float e0 = __expf(sc.tot0 - (sc.pre0 + sc.cl[i][0])), e1 = __expf(sc.tot1 - (sc.pre1 + sc.cl[i][1]));
            *p = pk2(bflo(w) * e0, bfhi(w) * e1); }
        if (oct == 0) *(f32x2*)(DEC + (size_t)unit * HD + 2 * dp) = (f32x2){__expf(sc.tot0), __expf(sc.tot1)};
        __syncthreads();
        f32x4 acc[8];
#pragma unroll
        for (int cb = 0; cb < 8; ++cb) acc[cb] = (f32x4){0.f, 0.f, 0.f, 0.f};
#pragma unroll
        for (int ks = 0; ks < 2; ++ks) { const bf16x8 bk = tile_tr(TK, lane, wave, ks);
#pragma unroll
            for (int cb = 0; cb < 8; ++cb) { const bf16x8 av = tile_tr(TV, lane, cb, ks); acc[cb] = mfma16(av, bk, acc[cb]); } }
        bf16_t* sp = S + (size_t)unit * (HD * HD) + (16 * wave + fr) * HD + 4 * g4;
#pragma unroll
        for (int cb = 0; cb < 8; ++cb) { u32x2 w; w.x = pk2(acc[cb][0], acc[cb][1]); w.y = pk2(acc[cb][2], acc[cb][3]); *(u32x2*)(sp + 16 * cb) = w; }
        __syncthreads();
    }
}

__device__ __forceinline__ void pool_ld(const bf16_t* U, int pu, u32x4 (&r)[5], int tid) {
    const int tile = pu >> 2, gi = pu & 3, row0 = tile * 64, w = 2 << gi, pos0 = row0 & (SEQ - 1), nrow = 64 + w - 1;
    const bf16_t* ug = U + ((ptrdiff_t)row0 - (w - 1)) * 1024 + 256 * gi;
#pragma unroll
    for (int it = 0; it < 5; ++it) { const int n = tid + NTHR * it, rr = n >> 5, ch = n & 31; r[it] = (u32x4){0u, 0u, 0u, 0u};
        if (n < nrow * 32 && pos0 - (w - 1) + rr >= 0) r[it] = *(const u32x4*)(ug + (ptrdiff_t)rr * 1024 + ch * 8); }
}
__device__ __forceinline__ void pool_phase(LAS unsigned char* lds, int bx, int G, const bf16_t* U, const bf16_t* WpT, const float* pscale, bf16_t* YCAT, int tid) {
    LAS unsigned char* TP = lds;
    LAS unsigned char* TU = lds + 33792;
    const unsigned lane = tid & 63, wave = tid >> 6, fr = lane & 15, g4 = lane >> 4;
    const int cp = tid & 127, tq = tid >> 7, tbeg = 16 * tq;
    bf16x8 wa[8][2]; int wgi = -1;
    u32x4 ru[5];
    if (bx < NPOOLU) pool_ld(U, bx, ru, tid);
    for (int pu = bx; pu < NPOOLU; pu += G) {
        const int tile = pu >> 2, gi = pu & 3, row0 = tile * 64, w = 2 << gi, pos0 = row0 & (SEQ - 1), nrow = 64 + w - 1;
#pragma unroll
        for (int it = 0; it < 5; ++it) { const int n = tid + NTHR * it, rr = n >> 5, ch = n & 31; if (n < nrow * 32) *(LAS u32x4*)(TU + rr * 528 + ch * 16) = ru[it]; }
        __syncthreads();
        if (pu + G < NPOOLU) pool_ld(U, pu + G, ru, tid);
        if (gi != wgi) { wgi = gi; const bf16_t* wb = WpT + (size_t)gi * 65536 + (size_t)(32 * wave + fr) * 256 + 8 * g4;
#pragma unroll
            for (int ks = 0; ks < 8; ++ks)
#pragma unroll
                for (int nbi = 0; nbi < 2; ++nbi) wa[ks][nbi] = *(const bf16x8*)(wb + nbi * 16 * 256 + 32 * ks); }
        {   const LAS unsigned char* tu = TU + (w - 1) * 528 + cp * 4;
            float r0 = 0.f, r1 = 0.f;
            for (int j = 1; j < w; ++j) { const unsigned x = *(const LAS unsigned*)(tu + (tbeg - j) * 528); r0 += bflo(x); r1 += bfhi(x); }
#pragma unroll 4
            for (int i = 0; i < 16; ++i) { const int t = tbeg + i; const unsigned x = *(const LAS unsigned*)(tu + t * 528); const float c0 = bflo(x), c1 = bfhi(x);
                r0 += c0; r1 += c1; const int cn = pos0 + t + 1; const float inv = 1.0f / (float)(cn < w ? cn : w);
                *(LAS unsigned*)(TP + t * 528 + cp * 4) = pk2(r0 * inv - c0, r1 * inv - c1);
                const unsigned xo = *(const LAS unsigned*)(tu + (t - w + 1) * 528); r0 -= bflo(xo); r1 -= bfhi(xo); } }
        __syncthreads();
        f32x4 acc[2][4];
#pragma unroll
        for (int a = 0; a < 2; ++a)
#pragma unroll
            for (int t = 0; t < 4; ++t) acc[a][t] = (f32x4){0.f, 0.f, 0.f, 0.f};
#pragma unroll
        for (int ks = 0; ks < 8; ++ks) {
            bf16x8 bq[4];
#pragma unroll
            for (int tb = 0; tb < 4; ++tb) bq[tb] = *(const LAS bf16x8*)(TP + (16 * tb + fr) * 528 + 64 * ks + 16 * g4);
#pragma unroll
            for (int nbi = 0; nbi < 2; ++nbi)
#pragma unroll
                for (int tb = 0; tb < 4; ++tb) acc[nbi][tb] = mfma16(wa[ks][nbi], bq[tb], acc[nbi][tb]);
        }
#pragma unroll
        for (int nbi = 0; nbi < 2; ++nbi) { const int n = 32 * wave + 16 * nbi + 4 * g4; const f32x4 sc = *(const f32x4*)(pscale + 256 * gi + n);
#pragma unroll
            for (int tb = 0; tb < 4; ++tb) { const f32x4 o = acc[nbi][tb] * sc; u32x2 wv; wv.x = pk2(o[0], o[1]); wv.y = pk2(o[2], o[3]);
                *(u32x2*)(YCAT + (size_t)(row0 + 16 * tb + fr) * DM + DH + 256 * gi + n) = wv; } }
        __syncthreads();
    }
}

#ifndef SCAN_U
#define SCAN_U 8
#endif
__device__ __forceinline__ void hgrn_scan(bf16_t* S, const float* DEC, int gtid, int gthreads) {
    for (int idx = gtid; idx < BATCH * NH * HD * HD / 4; idx += gthreads) {
        const int bh = idx >> 12, rem = idx & 4095, dk = rem >> 5;
        bf16_t* sp = S + (size_t)bh * NCH * (HD * HD) + rem * 4; const float* dp = DEC + (size_t)bh * NCH * HD + dk;
        f32x4 s = (f32x4){0.f, 0.f, 0.f, 0.f};
        for (int c0 = 0; c0 < NCH; c0 += SCAN_U) {
            u32x2 bw[SCAN_U]; float d[SCAN_U];
#pragma unroll
            for (int i = 0; i < SCAN_U; ++i) { bw[i] = *(const u32x2*)(sp + (size_t)(c0 + i) * (HD * HD)); d[i] = dp[(c0 + i) * HD]; }
#pragma unroll
            for (int i = 0; i < SCAN_U; ++i) { u32x2 o; o.x = pk2(s[0], s[1]); o.y = pk2(s[2], s[3]); *(u32x2*)(sp + (size_t)(c0 + i) * (HD * HD)) = o;
                s = s * d[i] + (f32x4){bflo(bw[i].x), bfhi(bw[i].x), bflo(bw[i].y), bfhi(bw[i].y)}; }
        }
    }
}

__device__ __forceinline__ void state_ld(const bf16_t* sg, u32x4 (&r)[4], int tid) {
#pragma unroll
    for (int it = 0; it < 4; ++it) { const int n = tid + NTHR * it, row = n >> 4, ch = n & 15; r[it] = *(const u32x4*)(sg + row * HD + ch * 8); }
}
__device__ __forceinline__ void hgrn_pass3_phase(LAS unsigned char* lds, int bx, int G, const bf16_t* Q, const bf16_t* Kk, const bf16_t* LF, const bf16_t* V, const bf16_t* Gt, const bf16_t* S,
                                                 const float* gnorm, bf16_t* YCAT, int tid) {
    LAS unsigned char* TQ = lds; LAS unsigned char* TK = lds + 16384; LAS unsigned char* TL = lds + 32768; LAS unsigned char* TV = lds + 49152; LAS unsigned char* TS = lds + 65536;
    LAS unsigned char* TA = lds + 98304; LAS float* PART = (LAS float*)(lds + 108544); LAS float* RED = (LAS float*)(lds + 112640); LAS unsigned char* TG = lds + 114688;
    const int dp = tid & 63, oct = tid >> 6;
    const unsigned lane = tid & 63, wave = tid >> 6, fr = lane & 15, g4 = lane >> 4;
    f32x4 gn[4];
#pragma unroll
    for (int cb = 0; cb < 4; ++cb) gn[cb] = *(const f32x4*)(gnorm + 16 * (4 * (wave >> 2) + cb) + 4 * g4);
    u32x4 rq[2], rk[2], rl[2], rv[2], rs[4], rg[2];
    if (bx < NUNIT) { const size_t go = unit_goff(bx); tile64_ld(Q + go, rq, tid); tile64_ld(Kk + go, rk, tid); tile64_ld(LF + go, rl, tid); tile64_ld(V + go, rv, tid); tile64_ld(Gt + go, rg, tid); state_ld(S + (size_t)bx * (HD * HD), rs, tid); }
    for (int unit = bx; unit < NUNIT; unit += G) {
        const int b = unit >> 10, h = (unit >> 7) & 7, c = unit & 127;
        const int row0 = b * SEQ + c * CH;
        tile64_st(rq, TQ, tid); tile64_st(rk, TK, tid); tile64_st(rl, TL, tid); tile64_st(rv, TV, tid); tile64_st(rg, TG, tid);
#pragma unroll
        for (int it = 0; it < 4; ++it) { const int n = tid + NTHR * it, row = n >> 4, ch = n & 15; *(LAS u32x4*)(TS + off_b(row, ch)) = rs[it]; }
        __syncthreads();
        if (unit + G < NUNIT) { const size_t go = unit_goff(unit + G); tile64_ld(Q + go, rq, tid); tile64_ld(Kk + go, rk, tid); tile64_ld(LF + go, rl, tid); tile64_ld(V + go, rv, tid); tile64_ld(Gt + go, rg, tid); state_ld(S + (size_t)(unit + G) * (HD * HD), rs, tid); }
        ScanOut sc; chunk_scan(TL, PART, dp, oct, sc);
#pragma unroll
        for (int i = 0; i < 8; ++i) { const unsigned o = off_b(8 * oct + i, dp >> 2) + 4 * (dp & 3);
            const unsigned qw = *(const LAS unsigned*)(TQ + o), kw = *(const LAS unsigned*)(TK + o);
            const float c0 = sc.pre0 + sc.cl[i][0], c1 = sc.pre1 + sc.cl[i][1];
            const float q0 = bflo(qw), q1 = bfhi(qw);
            *(LAS unsigned*)(TQ + o) = pk2(q0 * __expf(c0 - sc.mid0), q1 * __expf(c1 - sc.mid1));
            *(LAS unsigned*)(TK + o) = pk2(bflo(kw) * __expf(sc.mid0 - c0), bfhi(kw) * __expf(sc.mid1 - c1));
            *(LAS unsigned*)(TL + o) = pk2(q0 * __expf(c0), q1 * __expf(c1)); }
        __syncthreads();
        {
            const unsigned tb = wave >> 1;
#pragma unroll
            for (int sbi = 0; sbi < 2; ++sbi) { const unsigned sb = 2 * (wave & 1) + sbi; f32x4 a = (f32x4){0.f, 0.f, 0.f, 0.f};
#pragma unroll
                for (int ks = 0; ks < 4; ++ks) a = mfma16(tile_row(TK, lane, sb, ks), tile_row(TQ, lane, tb, ks), a);
                const int t = 16 * tb + fr, s0 = 16 * sb + 4 * g4;
                u32x2 w; w.x = pk2(s0 <= t ? a[0] : 0.f, s0 + 1 <= t ? a[1] : 0.f); w.y = pk2(s0 + 2 <= t ? a[2] : 0.f, s0 + 3 <= t ? a[3] : 0.f);
                *(LAS u32x2*)(TA + t * 144 + s0 * 2) = w; }
        }
        __syncthreads();
        const unsigned tb = wave & 3, dvh = wave >> 2;
        const int t = 16 * tb + fr;
        f32x4 acc[4];
#pragma unroll
        for (int cb = 0; cb < 4; ++cb) acc[cb] = (f32x4){0.f, 0.f, 0.f, 0.f};
#pragma unroll
        for (int ks = 0; ks < 2; ++ks) { const bf16x8 bq = *(const LAS bf16x8*)(TA + (16 * tb + fr) * 144 + 64 * ks + 16 * g4);
#pragma unroll
            for (int cb = 0; cb < 4; ++cb) acc[cb] = mfma16(tile_tr(TV, lane, 4 * dvh + cb, ks), bq, acc[cb]); }
#pragma unroll
        for (int ks = 0; ks < 4; ++ks) { const bf16x8 bq = tile_row(TL, lane, tb, ks);
#pragma unroll
            for (int cb = 0; cb < 4; ++cb) acc[cb] = mfma16(tile_tr(TS, lane, 4 * dvh + cb, ks), bq, acc[cb]); }
        float ss = 0.f;
#pragma unroll
        for (int cb = 0; cb < 4; ++cb) ss += (acc[cb][0] * acc[cb][0] + acc[cb][1] * acc[cb][1]) + (acc[cb][2] * acc[cb][2] + acc[cb][3] * acc[cb][3]);
        ss += __shfl_xor(ss, 16); ss += __shfl_xor(ss, 32);
        if (g4 == 0) RED[dvh * 64 + 16 * tb + fr] = ss;
        __syncthreads();
        const float r = rsqrtf((RED[16 * tb + fr] + RED[64 + 16 * tb + fr]) * (1.f / HD) + RMS_EPS);
#pragma unroll
        for (int cb = 0; cb < 4; ++cb) { const int dv = 16 * (4 * dvh + cb) + 4 * g4;
            const u32x2 gw = *(const LAS u32x2*)(TG + off_b(t, dv >> 3) + 2 * (dv & 7));
            const f32x4 sg = (f32x4){bflo(gw.x), bfhi(gw.x), bflo(gw.y), bfhi(gw.y)};
            const f32x4 o = acc[cb] * r * gn[cb] * sg; u32x2 wv; wv.x = pk2(o[0], o[1]); wv.y = pk2(o[2], o[3]);
            *(u32x2*)(YCAT + (size_t)(row0 + t) * DM + h * HD + dv) = wv; }
        __syncthreads();
    }
}
#define XB_TMO      128
#define XB_XCNT(j)  (256  + 64 * (j))
#define XB_XSUB(j)  (1280 + 64 * (j))
#define XB_XGEN(j)  (2304 + 64 * (j))
#define XB_TOP      3328
#define XB_TOPGEN   3392
#define XCD_BAR_WORDS 3456
#define XB_SPIN_CAP (1u << 18)

__device__ __forceinline__ unsigned xb_ld(unsigned* p)              { return __hip_atomic_load(p, __ATOMIC_RELAXED, __HIP_MEMORY_SCOPE_AGENT); }
__device__ __forceinline__ unsigned xb_add(unsigned* p, unsigned v) { return __hip_atomic_fetch_add(p, v, __ATOMIC_RELAXED, __HIP_MEMORY_SCOPE_AGENT); }
__device__ __forceinline__ unsigned xb_xcc_id() { return (unsigned)__builtin_amdgcn_s_getreg((3 << 11) | 20) & 0xFu; }
#define XB_SPIN(cond, bar) do { unsigned _sp = 0; while (cond) { __builtin_amdgcn_s_sleep(1); \
    if ((++_sp & 255u) == 0u) { if (xb_ld(&(bar)[XB_TMO])) break; if (_sp > XB_SPIN_CAP) { atomicAdd(&(bar)[XB_TMO], 1u); break; } } } } while (0)

struct XcdBarrier {
    unsigned* bar; unsigned x;
    volatile LAS unsigned* st;
};

__device__ __forceinline__ XcdBarrier xcd_barrier_post(unsigned* bar, volatile LAS unsigned* st) {
    XcdBarrier b; b.bar = bar; b.x = xb_xcc_id(); b.st = st;
    if (threadIdx.x == 0) (void)xb_add(&bar[XB_XCNT(b.x)], 1u);
    return b;
}
__device__ __forceinline__ void xcd_barrier_complete(unsigned* bar, unsigned x, unsigned& nloc, unsigned& nx) {
    const unsigned G = gridDim.x * gridDim.y * gridDim.z;
    unsigned sum, cnt, mine, sp = 0u;
    for (;;) {
        sum = 0u; cnt = 0u; mine = 0u;
#pragma unroll
        for (unsigned j = 0; j < 16; ++j) { const unsigned c = xb_ld(&bar[XB_XCNT(j)]); sum += c; cnt += (c > 0u) ? 1u : 0u; mine = (j == x) ? c : mine; }
        if (sum == G) break;
        __builtin_amdgcn_s_sleep(1);
        if ((++sp & 255u) == 0u) { if (xb_ld(&bar[XB_TMO])) break; if (sp > XB_SPIN_CAP) { atomicAdd(&bar[XB_TMO], 1u); break; } }
    }
    nloc = mine > 0u ? mine : 1u; nx = cnt > 0u ? cnt : 1u;
}

__device__ __forceinline__ void xcd_barrier(const XcdBarrier& b) {
    asm volatile("s_waitcnt vmcnt(0)" ::: "memory");
    __syncthreads();
    if (threadIdx.x == 0) {
        unsigned* bar = b.bar;
        __builtin_amdgcn_s_waitcnt(0);
        unsigned nloc = b.st[0], nx = b.st[1];
        if (nloc == 0u) { xcd_barrier_complete(bar, b.x, nloc, nx); b.st[0] = nloc; b.st[1] = nx; }
        const unsigned old = xb_add(&bar[XB_XSUB(b.x)], 1u);
        const unsigned gen = old / nloc;
        if (old + 1u == (gen + 1u) * nloc) {
            __builtin_amdgcn_fence(__ATOMIC_RELEASE, "agent");
            asm volatile("s_waitcnt vmcnt(0)" ::: "memory");
            const unsigned og = xb_add(&bar[XB_TOP], 1u);
            const unsigned tg = og / nx;
            if (og + 1u == (tg + 1u) * nx) xb_add(&bar[XB_TOPGEN], 1u);
            else XB_SPIN(xb_ld(&bar[XB_TOPGEN]) == tg, bar);
            __builtin_amdgcn_fence(__ATOMIC_ACQUIRE, "agent");
            xb_add(&bar[XB_XGEN(b.x)], 1u);
            asm volatile("s_waitcnt vmcnt(0)" ::: "memory");
        } else {
            XB_SPIN(xb_ld(&bar[XB_XGEN(b.x)]) == gen, bar);
            __builtin_amdgcn_fence(__ATOMIC_ACQUIRE, "agent");
            asm volatile("s_waitcnt vmcnt(0)" ::: "memory");
        }
    }
    __syncthreads();
}

#ifndef MK_N_LAUNCHES
#define MK_N_LAUNCHES 1
#endif
#ifndef WGM_GU
#define WGM_GU 4
#endif
#ifndef WGM_D
#define WGM_D 4
#endif
#ifndef WGM_IN
#define WGM_IN 4
#endif
#ifndef WGM_OUT
#define WGM_OUT 4
#endif
constexpr int N_PHASES = 13;
struct Params { const float* in[19]; float* out; unsigned char* ws; int ph_lo, ph_hi, li, pad; };
__global__ void __launch_bounds__(NTHR, 2) fwd_megakernel(Params p) {
    extern __shared__ __attribute__((aligned(16))) unsigned char lds_raw[];
    LAS unsigned char* lds = (LAS unsigned char*)lds_raw;
    cg::grid_group grid = cg::this_grid();
    const int tid = threadIdx.x, lane = tid & 63, wave = __builtin_amdgcn_readfirstlane(tid >> 6);
    const int G = gridDim.x, bx = blockIdx.x;
    const int gw = bx * NWAVES + wave, NGW = G * NWAVES;
    unsigned char* ws = p.ws;
    const float* x = p.in[0];
    bf16_t* Wgu1 = (bf16_t*)(ws + WS_WGU1); bf16_t* Wd1 = (bf16_t*)(ws + WS_WD1); bf16_t* Win = (bf16_t*)(ws + WS_WIN); bf16_t* Wout = (bf16_t*)(ws + WS_WOUT);
    bf16_t* Wpool = (bf16_t*)(ws + WS_WPOOL); bf16_t* Wgu2 = (bf16_t*)(ws + WS_WGU2); bf16_t* Wd2 = (bf16_t*)(ws + WS_WD2);
    bf16_t* Hb = (bf16_t*)(ws + WS_H); bf16_t* Yb = (bf16_t*)(ws + WS_Y); bf16_t* XN = (bf16_t*)(ws + WS_XN); bf16_t* YCAT = (bf16_t*)(ws + WS_YCAT);
    bf16_t* Qb = (bf16_t*)(ws + WS_Q); bf16_t* Kb = (bf16_t*)(ws + WS_K); bf16_t* LFb = (bf16_t*)(ws + WS_LF); bf16_t* Vb = (bf16_t*)(ws + WS_V); bf16_t* Gb = (bf16_t*)(ws + WS_G);
    bf16_t* Ub = (bf16_t*)(ws + WS_U); bf16_t* Sb = (bf16_t*)(ws + WS_S); float* DEC = (float*)(ws + WS_DEC); float* RS = (float*)(ws + WS_RS);
    const int lo = p.ph_lo, hi = p.ph_hi;
#define IN(k) (lo <= (k) && (k) < hi)
#define SEAM(k) do { if (IN(k) && IN((k) + 1)) xcd_barrier(bar); } while (0)
    volatile LAS unsigned* bst = (volatile LAS unsigned*)(lds + LDS_BYTES - 64);
    if (tid < 16) bst[tid] = 0u;
    __syncthreads();
    XcdBarrier bar; bar.bar = (unsigned*)ws + p.li * XCD_BAR_WORDS; bar.x = 0; bar.st = nullptr;
    if (hi - lo > 1) bar = xcd_barrier_post((unsigned*)ws + p.li * XCD_BAR_WORDS, bst);
    if (lo == -12345) grid.sync();

    if (IN(0)) {
        LAS float* scr = (LAS float*)(lds + wave * P0_SCR_BYTES);
        constexpr int I_GU = (DM / 64) * (FF / 64), I_D = (FF / 64) * (DM / 64), I_IN = (DM / 64) * (DIN / 64), I_OUT = (DM / 64) * (DM / 64), I_P = (256 / 64) * (256 / 64);
        static_assert(NWAVES * P0_SCR_BYTES <= LDS_BYTES - 64, "prologue scratch");
        constexpr int NITEMS = 4 * I_GU + 2 * I_D + I_IN + I_OUT + 4 * I_P;
        for (int it = gw; it < NITEMS; it += NGW) {
            int r = it;
            if (r < I_GU) { p0_matrix_item(p.in[2], DM, FF, Wgu1, 1, r, scr, lane, p.in[1]); continue; } r -= I_GU;
            if (r < I_GU) { p0_matrix_item(p.in[3], DM, FF, Wgu1, 2, r, scr, lane, p.in[1]); continue; } r -= I_GU;
            if (r < I_D) { p0_matrix_item(p.in[4], FF, DM, Wd1, 0, r, scr, lane); continue; } r -= I_D;
            if (r < I_IN) { p0_matrix_item(p.in[7], DM, DIN, Win, 0, r, scr, lane, p.in[6]); continue; } r -= I_IN;
            if (r < I_OUT) { p0_matrix_item(p.in[12], DM, DM, Wout, 0, r, scr, lane); continue; } r -= I_OUT;
            if (r < 4 * I_P) { const int gi = r / I_P; p0_matrix_item(p.in[10] + (size_t)gi * 65536, 256, 256, Wpool + (size_t)gi * 65536, 0, r % I_P, scr, lane); continue; } r -= 4 * I_P;
            if (r < I_GU) { p0_matrix_item(p.in[15], DM, FF, Wgu2, 1, r, scr, lane, p.in[14]); continue; } r -= I_GU;
            if (r < I_GU) { p0_matrix_item(p.in[16], DM, FF, Wgu2, 2, r, scr, lane, p.in[14]); continue; } r -= I_GU;
            p0_matrix_item(p.in[17], FF, DM, Wd2, 0, r, scr, lane);
        }
        rows_first(x, XN, RS, gw, NGW, lane);
        __syncthreads();
    }
    SEAM(0);
    if (IN(1)) { pg8::Gemm g{XN, Wgu1, M, 2 * FF, DM}; pg8::StaticOrder S; S.init(M, 2 * FF, G, bx, WGM_GU); pg8::EpiSwiglu E{Hb, FF, RS};
        pg8::gemm_phase<pg8::EpiSwiglu, pg8::StaticOrder, true, true>(lds, g, S, E); }
    SEAM(1);
    if (IN(2)) { pg8::Gemm g{Hb, Wd1, M, DM, FF}; pg8::StaticOrder S; S.init(M, DM, G, bx, WGM_D); pg8::EpiStore E{Yb, DM};
        pg8::gemm_phase<pg8::EpiStore, pg8::StaticOrder, true, true>(lds, g, S, E); }
    SEAM(2);
    if (IN(3)) rows_res<false>(x, Yb, 0.5f, p.in[5], XN, RS, nullptr, gw, NGW, lane);
    SEAM(3);
    if (IN(4)) { pg8::Gemm g{XN, Win, M, DIN, DM}; pg8::StaticOrder S; S.init(M, DIN, G, bx, WGM_IN); pg8::EpiWin E{Qb, Kb, LFb, Vb, Gb, Ub, p.in[8], RS};
        pg8::gemm_phase<pg8::EpiWin, pg8::StaticOrder, true, true>(lds, g, S, E); }
    SEAM(4);
    if (IN(5)) {
        hgrn_pass1_phase(lds, bx, G, Kb, LFb, Vb, Sb, DEC, tid);
        pool_phase(lds, bx, G, Ub, Wpool, p.in[11], YCAT, tid);
    }
    SEAM(5);
    if (IN(6)) hgrn_scan(Sb, DEC, bx * NTHR + tid, G * NTHR);
    SEAM(6);
    if (IN(7)) hgrn_pass3_phase(lds, bx, G, Qb, Kb, LFb, Vb, Gb, Sb, p.in[9], YCAT, tid);
    SEAM(7);
    if (IN(8)) { pg8::Gemm g{YCAT, Wout, M, DM, DM}; pg8::StaticOrder S; S.init(M, DM, G, bx, WGM_OUT); pg8::EpiStore E{Yb, DM};
        pg8::gemm_phase<pg8::EpiStore, pg8::StaticOrder, true, true>(lds, g, S, E); }
    SEAM(8);
    if (IN(9)) rows_res<false>(nullptr, Yb, 1.0f, p.in[13], XN, RS, nullptr, gw, NGW, lane);
    SEAM(9);
    if (IN(10)) { pg8::Gemm g{XN, Wgu2, M, 2 * FF, DM}; pg8::StaticOrder S; S.init(M, 2 * FF, G, bx, WGM_GU); pg8::EpiSwiglu E{Hb, FF, RS};
        pg8::gemm_phase<pg8::EpiSwiglu, pg8::StaticOrder, true, true>(lds, g, S, E); }
    SEAM(10);
    if (IN(11)) { pg8::Gemm g{Hb, Wd2, M, DM, FF}; pg8::StaticOrder S; S.init(M, DM, G, bx, WGM_D); pg8::EpiStore E{Yb, DM};
        pg8::gemm_phase<pg8::EpiStore, pg8::StaticOrder, true, true>(lds, g, S, E); }
    SEAM(11);
    if (IN(12)) rows_res<true>(nullptr, Yb, 0.5f, p.in[18], XN, nullptr, p.out, gw, NGW, lane);
#undef IN
#undef SEAM
}

extern "C" void kernel_launch(void* const* d_in, const int* in_sizes, int n_in, void* d_out, int out_size, void* d_ws, size_t ws_size, hipStream_t stream) {
    static int grid = 0;
    if (grid == 0) {
        if (n_in != 19 || in_sizes[0] != M * DM || out_size != M * DM || ws_size < WS_END) { fprintf(stderr, "kernel_launch: unexpected shapes (n_in %d in0 %d out %d ws %zu)\n", n_in, n_in > 0 ? in_sizes[0] : -1, out_size, ws_size); grid = -1; return; }
        int dev = 0, cus = 0, per_cu = 0;
        (void)hipGetDevice(&dev); (void)hipDeviceGetAttribute(&cus, hipDeviceAttributeMultiprocessorCount, dev);
        if (hipFuncSetAttribute((const void*)fwd_megakernel, hipFuncAttributeMaxDynamicSharedMemorySize, LDS_BYTES) != hipSuccess) { fprintf(stderr, "kernel_launch: hipFuncSetAttribute failed\n"); grid = -1; return; }
        if (hipOccupancyMaxActiveBlocksPerMultiprocessor(&per_cu, (const void*)fwd_megakernel, NTHR, LDS_BYTES) != hipSuccess || per_cu < 1) { fprintf(stderr, "kernel_launch: occupancy query says %d\n", per_cu); per_cu = 1; }
        (void)hipGetLastError();
        grid = cus * per_cu;
    }
    if (grid < 0) return;
    Params p{};
    for (int i = 0; i < 19; ++i) p.in[i] = (const float*)d_in[i];
    p.out = (float*)d_out; p.ws = (unsigned char*)d_ws;
#if MK_N_LAUNCHES == 1
    (void)hipMemsetAsync(d_ws, 0, 65536, stream);
    void* args[] = {&p};
#ifdef PROBE_PHASE
#ifndef PROBE_END
#define PROBE_END PROBE_PHASE
#endif
    p.ph_lo = 0; p.ph_hi = PROBE_END + 1;
    (void)hipLaunchCooperativeKernel((const void*)fwd_megakernel, dim3(grid), dim3(NTHR), args, LDS_BYTES, stream);
    p.ph_lo = PROBE_PHASE; p.ph_hi = PROBE_END + 1; p.li = 1;
    (void)hipLaunchCooperativeKernel((const void*)fwd_megakernel, dim3(grid), dim3(NTHR), args, LDS_BYTES, stream);
    p.ph_lo = PROBE_END + 1; p.ph_hi = N_PHASES; p.li = 2;
    (void)hipLaunchCooperativeKernel((const void*)fwd_megakernel, dim3(grid), dim3(NTHR), args, LDS_BYTES, stream);
#else
    p.ph_lo = 0; p.ph_hi = N_PHASES;
    hipError_t e = hipLaunchCooperativeKernel((const void*)fwd_megakernel, dim3(grid), dim3(NTHR), args, LDS_BYTES, stream);
    if (e != hipSuccess) fprintf(stderr, "cooperative launch failed: %s (grid %d)\n", hipGetErrorString(e), grid);
#endif
#else
    for (int ph = 0; ph < N_PHASES; ++ph) { p.ph_lo = ph; p.ph_hi = ph + 1; hipLaunchKernelGGL(fwd_megakernel, dim3(grid), dim3(NTHR), LDS_BYTES, stream, p); }
#endif
}
```

```cpp
#include <hip/hip_runtime.h>
#include <hip/hip_cooperative_groups.h>
#include <cstdio>
#include <cstdint>
namespace cg = cooperative_groups;
namespace pg8 {
#define PG8_LAS __attribute__((address_space(3)))
typedef unsigned short bf16_t;
typedef short bf16x8 __attribute__((ext_vector_type(8)));
typedef float f32x4 __attribute__((ext_vector_type(4)));
typedef unsigned u32x4 __attribute__((ext_vector_type(4)));
constexpr int BM = 256, BK = 64, HALF = 128, HTB = HALF * BK * 2  , STAGE_BYTES = 8 * HTB, NXCD = 8, WGM = 8;

__host__ __device__ __forceinline__ int lds_byte(int r, int c) { const int st = (r >> 4) * 2 + (c >> 5), rr = r & 15, cc = c & 31, ob = rr * 64 + cc * 2; return st * 1024 + (ob ^ (((ob >> 9) & 1) << 5)); }
__host__ __device__ __forceinline__ void stage_rc(int b, int& R, int& C) { const int st = b / 1024, sb = b % 1024, swz = sb ^ (((sb >> 9) & 1) << 5); R = (st >> 1) * 16 + swz / 64; C = (st & 1) * 32 + (swz % 64) / 2; }
__host__ __device__ __forceinline__ int perm32(int rho) { const int n = rho >> 4, i = rho & 15; return 8 * (i >> 2) + 4 * n + (i & 3); }

struct Unit { int pm, pn; };
struct Gemm { const bf16_t* A; const bf16_t* Bt; int M, N, K; };

struct StaticOrder {
    int nM, nN, nwg, G, c, wgm;
    __host__ __device__ void init(int M, int N, int G_, int c_, int wgm_ = WGM) { nM = M / BM; nN = N / BM; nwg = nM * nN; G = G_; c = c_; wgm = wgm_; }
    __host__ __device__ bool next(int i, Unit& u) const {
        const long L = (long)i * G + c; if (L >= nwg) return false;
        int wgid = (int)L; { const int q = nwg / NXCD, r = nwg % NXCD, xcd = wgid % NXCD, off = wgid / NXCD; wgid = (xcd < r ? xcd * (q + 1) : r * (q + 1) + (xcd - r) * q) + off; }
        const int nig = wgm * nN, gid = wgid / nig, fm = gid * wgm, gsz = (nM - fm) < wgm ? (nM - fm) : wgm;
        u.pm = fm + ((wgid % nig) % gsz); u.pn = (wgid % nig) / gsz; return true;
    }
    __device__ __forceinline__ void a_ready(const Unit&) const {}
    __device__ __forceinline__ void done(const Unit&) const {}
};

typedef __bf16 bf16v2_t __attribute__((ext_vector_type(2)));
typedef float f32x2 __attribute__((ext_vector_type(2)));
__device__ __forceinline__ unsigned cvt_pk_bf16(float lo, float hi) { const bf16v2_t v = __builtin_convertvector((f32x2){lo, hi}, bf16v2_t); return __builtin_bit_cast(unsigned, v); }
typedef unsigned u32x2 __attribute__((ext_vector_type(2)));
__device__ __forceinline__ float fast_sigmoid(float v) { return __builtin_amdgcn_rcpf(1.0f + __expf(-v)); }
__device__ __forceinline__ float silu_f(float v) { return v * fast_sigmoid(v); }
__device__ __forceinline__ void store8(bf16_t* p, const f32x4 v0, const f32x4 v1) {
    u32x4 w; w.x = cvt_pk_bf16(v0[0], v0[1]); w.y = cvt_pk_bf16(v0[2], v0[3]); w.z = cvt_pk_bf16(v1[0], v1[1]); w.w = cvt_pk_bf16(v1[2], v1[3]);
    *(u32x4*)p = w;
}
struct EpiStore {
    static constexpr bool PERM = true, AFTER_DRAIN = false;
    bf16_t* O; int ldc;
    struct Pre {};
    __device__ __forceinline__ void prefetch(Pre&, const Unit&, int, int) const {}
    __device__ __forceinline__ void operator()(const f32x4 (&acc)[2][2][4][2], const Unit& u, int wr, int wc, int fr, int fq, const Pre&) const {
        const int row0 = u.pm * BM + wr * 64 + fr, col0 = u.pn * BM + wc * 32 + 8 * fq;
#pragma unroll
        for (int ai = 0; ai < 2; ++ai)
#pragma unroll
            for (int m = 0; m < 4; ++m) { bf16_t* rowp = O + (size_t)(row0 + ai * HALF + m * 16) * ldc + col0;
#pragma unroll
                for (int bj = 0; bj < 2; ++bj) store8(rowp + bj * HALF, acc[ai][bj][m][0], acc[ai][bj][m][1]); }
    }
};
struct EpiSwiglu {
    static constexpr bool PERM = true, AFTER_DRAIN = false;
    bf16_t* O; int ldc; const float* rs;
    struct Pre { float r[2][4]; };
    __device__ __forceinline__ void prefetch(Pre& p, const Unit& u, int wr, int fr) const {
#pragma unroll
        for (int ai = 0; ai < 2; ++ai)
#pragma unroll
            for (int m = 0; m < 4; ++m) p.r[ai][m] = rs[u.pm * BM + wr * 64 + fr + ai * HALF + m * 16];
    }
    __device__ __forceinline__ void operator()(const f32x4 (&acc)[2][2][4][2], const Unit& u, int wr, int wc, int fr, int fq, const Pre& pre) const {
        const int row0 = u.pm * BM + wr * 64 + fr, col0 = u.pn * HALF + wc * 32 + 8 * fq;
#pragma unroll
        for (int ai = 0; ai < 2; ++ai)
#pragma unroll
            for (int m = 0; m < 4; ++m) { bf16_t* rowp = O + (size_t)(row0 + ai * HALF + m * 16) * ldc + col0;
                f32x4 h0, h1; const float r = pre.r[ai][m];
#pragma unroll
                for (int j = 0; j < 4; ++j) { h0[j] = silu_f(r * acc[ai][0][m][0][j]) * (r * acc[ai][1][m][0][j]); h1[j] = silu_f(r * acc[ai][0][m][1][j]) * (r * acc[ai][1][m][1][j]); }
                store8(rowp, h0, h1); }
    }
};
struct EpiWin {
    static constexpr bool PERM = true, AFTER_DRAIN = false;
    bf16_t *Q, *Kk, *LF, *V, *G, *U; const float* lbl; const float* rs;
    struct Pre { float r[2][4]; };
    __device__ __forceinline__ void prefetch(Pre& p, const Unit& u, int wr, int fr) const {
#pragma unroll
        for (int ai = 0; ai < 2; ++ai)
#pragma unroll
            for (int m = 0; m < 4; ++m) p.r[ai][m] = rs[u.pm * BM + wr * 64 + fr + ai * HALF + m * 16];
    }
    __device__ __forceinline__ void operator()(const f32x4 (&acc)[2][2][4][2], const Unit& u, int wr, int wc, int fr, int fq, const Pre& pre) const {
        const int seg = u.pn >> 2, colt = (u.pn & 3) * BM;
        const int row0 = u.pm * BM + wr * 64 + fr, col0 = colt + wc * 32 + 8 * fq;
        if (seg == 1) {
            f32x4 lb[2][2], om[2][2];
#pragma unroll
            for (int bj = 0; bj < 2; ++bj)
#pragma unroll
                for (int n = 0; n < 2; ++n) { const f32x4 a0 = *(const f32x4*)(lbl + col0 + bj * HALF + 4 * n), a1 = *(const f32x4*)(lbl + 1024 + col0 + bj * HALF + 4 * n);
#pragma unroll
                    for (int j = 0; j < 4; ++j) { const float l = 1.0f / (1.0f + __expf(a1[j] - a0[j])); lb[bj][n][j] = l; om[bj][n][j] = 1.0f - l; } }
#pragma unroll
            for (int ai = 0; ai < 2; ++ai)
#pragma unroll
                for (int m = 0; m < 4; ++m) { const size_t ro = (size_t)(row0 + ai * HALF + m * 16) * 1024 + col0; const float r = pre.r[ai][m];
#pragma unroll
                    for (int bj = 0; bj < 2; ++bj) { f32x4 k0, k1, l0, l1;
#pragma unroll
                        for (int j = 0; j < 4; ++j) {
                            const float z0 = r * acc[ai][bj][m][0][j], z1 = r * acc[ai][bj][m][1][j];
                            const float s0 = fast_sigmoid(z0), s1 = fast_sigmoid(z1);
                            const float f0 = lb[bj][0][j] + om[bj][0][j] * s0, f1 = lb[bj][1][j] + om[bj][1][j] * s1;
                            k0[j] = om[bj][0][j] * (1.0f - s0); k1[j] = om[bj][1][j] * (1.0f - s1);
                            l0[j] = __logf(f0); l1[j] = __logf(f1); }
                        store8(Kk + ro + bj * HALF, k0, k1); store8(LF + ro + bj * HALF, l0, l1); } }
        } else {
            bf16_t* O = seg == 0 ? Q : (seg == 2 ? V : (seg == 3 ? G : U));
#pragma unroll
            for (int ai = 0; ai < 2; ++ai)
#pragma unroll
                for (int m = 0; m < 4; ++m) { bf16_t* rowp = O + (size_t)(row0 + ai * HALF + m * 16) * 1024 + col0; const float r = pre.r[ai][m];
#pragma unroll
                    for (int bj = 0; bj < 2; ++bj) { f32x4 v0 = acc[ai][bj][m][0] * r, v1 = acc[ai][bj][m][1] * r;
                        if (seg == 3) {
#pragma unroll
                            for (int j = 0; j < 4; ++j) { v0[j] = silu_f(v0[j]); v1[j] = silu_f(v1[j]); } }
                        store8(rowp + bj * HALF, v0, v1); } }
        }
    }
};

template <class Epi, class Sched, bool ALIGN_EPI = false, bool SP2 = false>
__device__ __forceinline__ void gemm_phase(PG8_LAS unsigned char* lds, const Gemm g, const Sched& S, const Epi& E) {
    const int tid = threadIdx.x, wid = __builtin_amdgcn_readfirstlane(tid >> 6), lane = tid & 63, wr = wid >> 2, wc = wid & 3, fr = lane & 15, fq = lane >> 4;
    const int K = g.K, nt = K / BK;
    unsigned voffA[2], voffB[2];
#pragma unroll
    for (int i = 0; i < 2; ++i) { int R, C; stage_rc(tid * 16 + i * 8192, R, C); const int Rb = Epi::PERM ? ((R & ~31) + perm32(R & 31)) : R;
        voffA[i] = (unsigned)(R * K + C) * 2u; voffB[i] = (unsigned)(Rb * K + C) * 2u; }
    const size_t kstep = (size_t)(BK * 2);
    const size_t hstep = (size_t)HALF * K * 2;
    const size_t tstep = 2 * hstep;
    const unsigned ldsw = (unsigned)wid * 1024u;
    const int aoff = lds_byte(wr * 64 + fr, fq * 8), boff = lds_byte(wc * 32 + fr, fq * 8);
#define PG8_SA(b, h) (((b) * 2 + (h)) * HTB)
#define PG8_SB(b, h) ((4 + (b) * 2 + (h)) * HTB)
#define PG8_STAGE(bufoff, gbase, voff) do { _Pragma("unroll") for (int _i = 0; _i < 2; ++_i) \
        __builtin_amdgcn_global_load_lds((const unsigned*)((const char*)(gbase) + (voff)[_i]), (PG8_LAS unsigned*)(lds + (bufoff) + ldsw + _i * 8192), 16, 0, 0); } while (0)
#define PG8_LDA(dst, b, h) do { _Pragma("unroll") for (int m = 0; m < 4; ++m) _Pragma("unroll") for (int k = 0; k < 2; ++k) dst[m][k] = *(const PG8_LAS bf16x8*)(lds + PG8_SA(b, h) + aoff + m * 2048 + k * 1024); } while (0)
#define PG8_LDB(dst, b, h) do { _Pragma("unroll") for (int n = 0; n < 2; ++n) _Pragma("unroll") for (int k = 0; k < 2; ++k) dst[n][k] = *(const PG8_LAS bf16x8*)(lds + PG8_SB(b, h) + boff + n * 2048 + k * 1024); } while (0)
#define PG8_MF1(ai, bj, At, Bt, m, n, k) do { acc[ai][bj][m][n] = __builtin_amdgcn_mfma_f32_16x16x32_bf16(Bt[n][k], At[m][k], acc[ai][bj][m][n], 0, 0, 0); __builtin_amdgcn_sched_barrier(0); } while (0)
#define PG8_MMA(ai, bj, At, Bt) do { __builtin_amdgcn_s_setprio(1); __builtin_amdgcn_sched_barrier(0); \
        PG8_MF1(ai, bj, At, Bt, 0, 0, 0); PG8_MF1(ai, bj, At, Bt, 0, 1, 0); PG8_MF1(ai, bj, At, Bt, 1, 1, 0); PG8_MF1(ai, bj, At, Bt, 1, 0, 0); \
        PG8_MF1(ai, bj, At, Bt, 2, 0, 0); PG8_MF1(ai, bj, At, Bt, 2, 1, 0); PG8_MF1(ai, bj, At, Bt, 3, 1, 0); PG8_MF1(ai, bj, At, Bt, 3, 0, 0); \
        PG8_MF1(ai, bj, At, Bt, 0, 0, 1); PG8_MF1(ai, bj, At, Bt, 0, 1, 1); PG8_MF1(ai, bj, At, Bt, 1, 1, 1); PG8_MF1(ai, bj, At, Bt, 1, 0, 1); \
        PG8_MF1(ai, bj, At, Bt, 2, 0, 1); PG8_MF1(ai, bj, At, Bt, 2, 1, 1); PG8_MF1(ai, bj, At, Bt, 3, 1, 1); PG8_MF1(ai, bj, At, Bt, 3, 0, 1); \
        __builtin_amdgcn_s_setprio(0); } while (0)
#define PG8_WAIT_V(n) asm volatile("s_waitcnt vmcnt(" #n ")" ::: "memory")
#define PG8_WAIT_L(n) asm volatile("s_waitcnt lgkmcnt(" #n ")" ::: "memory")
#define PG8_BAR __builtin_amdgcn_s_barrier()
#define PG8_SCHED __builtin_amdgcn_sched_barrier(0)
    Unit cur, nxt; int ui = 0;
    if (!S.next(0, cur)) return;
    f32x4 acc[2][2][4][2];
#pragma unroll
    for (int a = 0; a < 2; ++a)
#pragma unroll
        for (int b = 0; b < 2; ++b)
#pragma unroll
            for (int m = 0; m < 4; ++m)
#pragma unroll
                for (int n = 0; n < 2; ++n) acc[a][b][m][n] = (f32x4){0.f, 0.f, 0.f, 0.f};
    bf16x8 At[4][2], B0[2][2], B1[2][2];
    const char* cA = (const char*)g.A + (size_t)cur.pm * tstep; const char* cB = (const char*)g.Bt + (size_t)cur.pn * tstep;
    S.a_ready(cur);
    typename Epi::Pre pre; E.prefetch(pre, cur, wr, fr);
    if constexpr (SP2) {
        PG8_STAGE(PG8_SB(0, 0), cB, voffB); PG8_STAGE(PG8_SB(0, 1), cB + hstep, voffB); PG8_STAGE(PG8_SA(0, 0), cA, voffA); PG8_STAGE(PG8_SA(0, 1), cA + hstep, voffA);
        if (wr == 1) PG8_BAR;
        PG8_WAIT_V(2); PG8_BAR;
        PG8_STAGE(PG8_SB(1, 0), cB + kstep, voffB); PG8_STAGE(PG8_SA(1, 0), cA + kstep, voffA); PG8_STAGE(PG8_SB(1, 1), cB + hstep + kstep, voffB);
        PG8_WAIT_V(6); PG8_BAR;
    } else {
        PG8_STAGE(PG8_SB(0, 0), cB, voffB); PG8_STAGE(PG8_SA(0, 0), cA, voffA); PG8_STAGE(PG8_SB(0, 1), cB + hstep, voffB); PG8_STAGE(PG8_SA(0, 1), cA + hstep, voffA);
        if (wr == 1) PG8_BAR;
        PG8_WAIT_V(4); PG8_BAR;
        PG8_STAGE(PG8_SB(1, 0), cB + kstep, voffB); PG8_STAGE(PG8_SA(1, 0), cA + kstep, voffA); PG8_STAGE(PG8_SB(1, 1), cB + hstep + kstep, voffB);
        PG8_WAIT_V(6); PG8_BAR;
    }
    for (;;) {
        const bool has_next = S.next(ui + 1, nxt);
        const char* nA = has_next ? (const char*)g.A + (size_t)nxt.pm * tstep : cA; const char* nB = has_next ? (const char*)g.Bt + (size_t)nxt.pn * tstep : cB;
        for (int t = 0; t < nt; t += 2) {
            const bool last = (t == nt - 2);
            const char* a1 = cA + (size_t)(t + 1) * kstep;
            const char* a2 = last ? nA : cA + (size_t)(t + 2) * kstep; const char* b2 = last ? nB : cB + (size_t)(t + 2) * kstep;
            const char* a3 = a2 + kstep; const char* b3 = b2 + kstep;
            if (last && has_next) S.a_ready(nxt);
            if constexpr (SP2) {
            PG8_LDB(B0, 0, 0); PG8_LDB(B1, 0, 1); PG8_SCHED; PG8_LDA(At, 0, 0); PG8_STAGE(PG8_SA(1, 1), a1 + hstep, voffA);
            PG8_WAIT_V(8); PG8_WAIT_L(0); PG8_BAR; PG8_MMA(0, 0, At, B0); PG8_MMA(0, 1, At, B1); PG8_BAR; PG8_SCHED;
            PG8_LDA(At, 0, 1); PG8_STAGE(PG8_SB(0, 0), b2, voffB); PG8_STAGE(PG8_SB(0, 1), b2 + hstep, voffB); PG8_STAGE(PG8_SA(0, 0), a2, voffA);
            PG8_WAIT_V(8); PG8_WAIT_L(0); PG8_BAR; PG8_MMA(1, 0, At, B0); PG8_MMA(1, 1, At, B1); PG8_BAR; PG8_SCHED;
            PG8_LDB(B0, 1, 0); PG8_LDB(B1, 1, 1); PG8_SCHED; PG8_LDA(At, 1, 0); PG8_STAGE(PG8_SA(0, 1), a2 + hstep, voffA);
            PG8_WAIT_V(8); PG8_WAIT_L(0); PG8_BAR; PG8_MMA(0, 0, At, B0); PG8_MMA(0, 1, At, B1); PG8_BAR; PG8_SCHED;
            PG8_LDA(At, 1, 1); PG8_STAGE(PG8_SB(1, 0), b3, voffB); PG8_STAGE(PG8_SB(1, 1), b3 + hstep, voffB); PG8_STAGE(PG8_SA(1, 0), a3, voffA);
            PG8_WAIT_V(8); PG8_WAIT_L(0); PG8_BAR; PG8_MMA(1, 0, At, B0); PG8_MMA(1, 1, At, B1); PG8_BAR; PG8_SCHED;
            } else {
            PG8_LDB(B0, 0, 0); PG8_SCHED; PG8_LDA(At, 0, 0); PG8_STAGE(PG8_SA(1, 1), a1 + hstep, voffA);
            PG8_WAIT_L(8); PG8_BAR; PG8_WAIT_L(0); PG8_MMA(0, 0, At, B0); PG8_BAR; PG8_SCHED;
            PG8_LDB(B1, 0, 1); PG8_STAGE(PG8_SB(0, 0), b2, voffB);
            PG8_BAR; PG8_WAIT_L(0); PG8_MMA(0, 1, At, B1); PG8_BAR;
            PG8_LDA(At, 0, 1); PG8_STAGE(PG8_SA(0, 0), a2, voffA);
            PG8_BAR; PG8_WAIT_L(0); PG8_MMA(1, 0, At, B0); PG8_BAR; PG8_SCHED;
            PG8_STAGE(PG8_SB(0, 1), b2 + hstep, voffB);
            PG8_WAIT_V(6); PG8_BAR; PG8_MMA(1, 1, At, B1); PG8_BAR;
            PG8_LDB(B0, 1, 0); PG8_SCHED; PG8_LDA(At, 1, 0); PG8_STAGE(PG8_SA(0, 1), a2 + hstep, voffA);
            PG8_WAIT_L(8); PG8_BAR; PG8_WAIT_L(0); PG8_MMA(0, 0, At, B0); PG8_BAR; PG8_SCHED;
            PG8_LDB(B1, 1, 1); PG8_STAGE(PG8_SB(1, 0), b3, voffB);
            PG8_BAR; PG8_WAIT_L(0); PG8_MMA(0, 1, At, B1); PG8_BAR;
            PG8_LDA(At, 1, 1); PG8_STAGE(PG8_SA(1, 0), a3, voffA);
            PG8_BAR; PG8_WAIT_L(0); PG8_MMA(1, 0, At, B0); PG8_BAR; PG8_SCHED;
            PG8_STAGE(PG8_SB(1, 1), b3 + hstep, voffB);
            PG8_WAIT_V(6); PG8_BAR; PG8_MMA(1, 1, At, B1); PG8_BAR;
            }
        }
        if constexpr (ALIGN_EPI) { if (wr == 0) PG8_BAR; }
        if constexpr (!Epi::AFTER_DRAIN) { E(acc, cur, wr, wc, fr, fq, pre); S.done(cur); }
        if (!has_next) break;
#pragma unroll
        for (int a = 0; a < 2; ++a)
#pragma unroll
            for (int b = 0; b < 2; ++b)
#pragma unroll
                for (int m = 0; m < 4; ++m)
#pragma unroll
                    for (int n = 0; n < 2; ++n) acc[a][b][m][n] = (f32x4){0.f, 0.f, 0.f, 0.f};
        cur = nxt; cA = nA; cB = nB; ++ui;
        E.prefetch(pre, cur, wr, fr);
        if constexpr (ALIGN_EPI) { if (wr == 1) PG8_BAR; }
    }
    PG8_WAIT_V(0);
    if constexpr (!ALIGN_EPI) { if (wr == 0) PG8_BAR; }
    PG8_BAR;
#undef PG8_SA
#undef PG8_SB
#undef PG8_STAGE
#undef PG8_LDA
#undef PG8_LDB
#undef PG8_MMA
#undef PG8_MF1
#undef PG8_WAIT_V
#undef PG8_WAIT_L
#undef PG8_BAR
#undef PG8_SCHED
}
}
using pg8::bf16_t; using pg8::bf16x8; using pg8::f32x4; using pg8::u32x4; using pg8::f32x2; using pg8::u32x2;
#define LAS __attribute__((address_space(3)))
constexpr int NWAVES = 8, NTHR = NWAVES * 64;
constexpr int BATCH = 4, SEQ = 8192, DM = 2048, M = BATCH * SEQ, FF = 5632, DH = 1024, HD = 128, NH = 8, DP = 1024, DIN = 5120;
constexpr int CH = 64, NCH = SEQ / CH, NUNIT = BATCH * NH * NCH;
constexpr int NPOOLU = (M / 64) * 4;
constexpr float RMS_EPS = 1e-6f;
constexpr size_t MiB = 1u << 20;
constexpr size_t WS_WGU1 = 1 * MiB, WS_WD1 = 45 * MiB, WS_WIN = 67 * MiB, WS_WOUT = 87 * MiB, WS_WPOOL = 95 * MiB, WS_WGU2 = 96 * MiB, WS_WD2 = 140 * MiB;
constexpr size_t WS_H = 162 * MiB;
constexpr size_t WS_Q = 162 * MiB, WS_K = 226 * MiB, WS_LF = 290 * MiB, WS_V = 354 * MiB, WS_G = 418 * MiB;
constexpr size_t WS_Y = 514 * MiB;
constexpr size_t WS_S = WS_Y;
constexpr size_t WS_XN = 642 * MiB;
constexpr size_t WS_YCAT = 770 * MiB;
constexpr size_t WS_U = 898 * MiB;
constexpr size_t WS_DEC = 962 * MiB;
constexpr size_t WS_RS = 964 * MiB;
constexpr size_t WS_END = 965 * MiB;
constexpr int LDS_BYTES = 147456;

__device__ __forceinline__ float bf2f(unsigned short b) { return __builtin_bit_cast(float, (unsigned)b << 16); }
__device__ __forceinline__ float bflo(unsigned w) { return __builtin_bit_cast(float, w << 16); }
__device__ __forceinline__ float bfhi(unsigned w) { return __builtin_bit_cast(float, w & 0xffff0000u); }
__device__ __forceinline__ unsigned pk2(float lo, float hi) { return pg8::cvt_pk_bf16(lo, hi); }
__device__ __forceinline__ float wave_sum(float v) {
#pragma unroll
    for (int o = 1; o < 64; o <<= 1) v += __shfl_xor(v, o);
    return v;
}
#define LDS_WAIT() asm volatile("s_waitcnt lgkmcnt(0)" ::: "memory")

constexpr int P0_PITCH = 68, P0_SCR_BYTES = 64 * P0_PITCH * 4;
__device__ __forceinline__ void p0_transpose_item(const float* W, int K, int N, bf16_t* WT, int k0, int n0, int drow0, LAS float* scr, int lane, const float* gk) {
    const int lr = lane >> 4, lc = lane & 15;
    f32x4 v[16];
#pragma unroll
    for (int i = 0; i < 16; ++i) v[i] = *(const f32x4*)(W + (size_t)(k0 + 4 * i + lr) * N + n0 + 4 * lc);
#pragma unroll
    for (int i = 0; i < 16; ++i) { const float gsc = gk ? gk[k0 + 4 * i + lr] : 1.0f; *(LAS f32x4*)(scr + (4 * i + lr) * P0_PITCH + 4 * lc) = v[i] * gsc; }
    LDS_WAIT(); asm volatile("" ::: "memory");
    const int c = lane & 7;
#pragma unroll
    for (int j = 0; j < 8; ++j) { const int n = (lane >> 3) + 8 * j; const LAS float* s = scr + (8 * c) * P0_PITCH + n;
        u32x4 o; o.x = pk2(s[0 * P0_PITCH], s[1 * P0_PITCH]); o.y = pk2(s[2 * P0_PITCH], s[3 * P0_PITCH]); o.z = pk2(s[4 * P0_PITCH], s[5 * P0_PITCH]); o.w = pk2(s[6 * P0_PITCH], s[7 * P0_PITCH]);
        *(u32x4*)(WT + (size_t)(drow0 + n) * K + k0 + 8 * c) = o; }
    LDS_WAIT(); asm volatile("" ::: "memory");
}
__device__ __forceinline__ void p0_matrix_item(const float* W, int K, int N, bf16_t* WT, int mode, int item, LAS float* scr, int lane, const float* gk = nullptr) {
    const int nblk = N / 64, kb = item / nblk, nb = item % nblk, n0 = 64 * nb;
    const int drow0 = mode == 0 ? n0 : (256 * (n0 >> 7) + (n0 & 127) + (mode == 2 ? 128 : 0));
    p0_transpose_item(W, K, N, WT, 64 * kb, n0, drow0, scr, lane, gk);
}

__device__ __forceinline__ void rows_first(const float* __restrict__ x, bf16_t* __restrict__ XB, float* __restrict__ RS, int gw, int NGW, int lane) {
    for (int m0 = gw; m0 < M; m0 += 2 * NGW) {
        const int m1 = (m0 + NGW < M) ? m0 + NGW : m0;
        f32x4 v[2][8]; float s[2] = {0.f, 0.f};
#pragma unroll
        for (int q = 0; q < 2; ++q) { const f32x4* xr = (const f32x4*)(x + (size_t)(q ? m1 : m0) * DM) + lane;
#pragma unroll
            for (int j = 0; j < 8; ++j) v[q][j] = xr[64 * j]; }
#pragma unroll
        for (int q = 0; q < 2; ++q) {
#pragma unroll
            for (int j = 0; j < 8; ++j) s[q] += (v[q][j].x * v[q][j].x + v[q][j].y * v[q][j].y) + (v[q][j].z * v[q][j].z + v[q][j].w * v[q][j].w);
            u32x2* o = (u32x2*)(XB + (size_t)(q ? m1 : m0) * DM) + lane;
#pragma unroll
            for (int j = 0; j < 8; ++j) { u32x2 w; w.x = pk2(v[q][j].x, v[q][j].y); w.y = pk2(v[q][j].z, v[q][j].w); o[64 * j] = w; } }
        const float r0 = rsqrtf(wave_sum(s[0]) * (1.f / DM) + RMS_EPS), r1 = rsqrtf(wave_sum(s[1]) * (1.f / DM) + RMS_EPS);
        if (lane == 0) { RS[m0] = r0; RS[m1] = r1; }
    }
}
template <bool FINAL>
__device__ __forceinline__ void rows_res(const float* xf, const bf16_t* Y, float coef, const float* g1, bf16_t* XB, float* RS, float* out, int gw, int NGW, int lane) {
    for (int m = gw; m < M; m += NGW) {
        const u32x2* yr = (const u32x2*)(Y + (size_t)m * DM) + lane;
        f32x4 v[8], y[8]; float s = 0.f;
        if (xf) { const f32x4* xr = (const f32x4*)(xf + (size_t)m * DM) + lane;
#pragma unroll
            for (int j = 0; j < 8; ++j) v[j] = xr[64 * j];
        } else { const u32x2* xr = (const u32x2*)(XB + (size_t)m * DM) + lane;
#pragma unroll
            for (int j = 0; j < 8; ++j) { const u32x2 w = xr[64 * j]; v[j] = (f32x4){bflo(w.x), bfhi(w.x), bflo(w.y), bfhi(w.y)}; } }
#pragma unroll
        for (int j = 0; j < 8; ++j) { const u32x2 w = yr[64 * j]; y[j] = (f32x4){bflo(w.x), bfhi(w.x), bflo(w.y), bfhi(w.y)};
            s += (y[j].x * y[j].x + y[j].y * y[j].y) + (y[j].z * y[j].z + y[j].w * y[j].w); }
        const float r1 = coef * rsqrtf(wave_sum(s) * (1.f / DM) + RMS_EPS);
        float s2 = 0.f;
#pragma unroll
        for (int j = 0; j < 8; ++j) { const f32x4 gg = *((const f32x4*)g1 + lane + 64 * j); v[j] = v[j] + y[j] * r1 * gg;
            s2 += (v[j].x * v[j].x + v[j].y * v[j].y) + (v[j].z * v[j].z + v[j].w * v[j].w); }
        if (FINAL) { f32x4* xw = (f32x4*)(out + (size_t)m * DM) + lane;
#pragma unroll
            for (int j = 0; j < 8; ++j) xw[64 * j] = v[j];
        } else {
            u32x2* o = (u32x2*)(XB + (size_t)m * DM) + lane;
#pragma unroll
            for (int j = 0; j < 8; ++j) { u32x2 w; w.x = pk2(v[j].x, v[j].y); w.y = pk2(v[j].z, v[j].w); o[64 * j] = w; }
            const float r2 = rsqrtf(wave_sum(s2) * (1.f / DM) + RMS_EPS);
            if (lane == 0) RS[m] = r2;
        }
    }
}

__device__ __forceinline__ unsigned off_b(unsigned row, unsigned ch) { return 256u * row + 16u * (ch ^ (((row & 3u) << 2) | ((row >> 2) & 3u))); }
__device__ __forceinline__ unsigned row_addr16(unsigned lane, unsigned rb, unsigned s) { return off_b((lane & 15) + 16 * rb, 4 * s + (lane >> 4)); }
__device__ __forceinline__ unsigned tr_addr16(unsigned lane, unsigned c, unsigned ks, unsigned t) { const unsigned g = lane >> 4, q = (lane & 15) >> 2, p = lane & 3; return off_b(32 * ks + 8 * g + 4 * t + q, 2 * c + (p >> 1)) + 8 * (p & 1); }
typedef short s16x4 __attribute__((ext_vector_type(4)));
__device__ __forceinline__ bf16x8 tile_tr(LAS unsigned char* tile, unsigned lane, unsigned c, unsigned ks) {
    const s16x4 lo = __builtin_amdgcn_ds_read_tr16_b64_v4i16((LAS s16x4*)(tile + tr_addr16(lane, c, ks, 0)));
    const s16x4 hi = __builtin_amdgcn_ds_read_tr16_b64_v4i16((LAS s16x4*)(tile + tr_addr16(lane, c, ks, 1)));
    return (bf16x8){lo[0], lo[1], lo[2], lo[3], hi[0], hi[1], hi[2], hi[3]};
}
__device__ __forceinline__ bf16x8 tile_row(LAS unsigned char* tile, unsigned lane, unsigned rb, unsigned s) { return *(const LAS bf16x8*)(tile + row_addr16(lane, rb, s)); }
__device__ __forceinline__ f32x4 mfma16(bf16x8 a, bf16x8 b, f32x4 c) { return __builtin_amdgcn_mfma_f32_16x16x32_bf16(a, b, c, 0, 0, 0); }

__device__ __forceinline__ void tile64_ld(const bf16_t* g, u32x4 (&r)[2], int tid) {
#pragma unroll
    for (int it = 0; it < 2; ++it) { const int n = tid + NTHR * it, row = n >> 4, ch = n & 15; r[it] = *(const u32x4*)(g + (size_t)row * 1024 + ch * 8); }
}
__device__ __forceinline__ void tile64_st(const u32x4 (&r)[2], LAS unsigned char* tile, int tid) {
#pragma unroll
    for (int it = 0; it < 2; ++it) { const int n = tid + NTHR * it, row = n >> 4, ch = n & 15; *(LAS u32x4*)(tile + off_b(row, ch)) = r[it]; }
}
struct ScanOut { float cl[8][2]; float pre0, pre1, tot0, tot1, mid0, mid1; };
__device__ __forceinline__ void chunk_scan(LAS unsigned char* TL, LAS float* PART, int dp, int oct, ScanOut& o) {
    float r0 = 0.f, r1 = 0.f;
#pragma unroll
    for (int i = 0; i < 8; ++i) { const unsigned w = *(const LAS unsigned*)(TL + off_b(8 * oct + i, dp >> 2) + 4 * (dp & 3)); r0 += bflo(w); r1 += bfhi(w); o.cl[i][0] = r0; o.cl[i][1] = r1; }
    *(LAS f32x2*)(PART + oct * 128 + 2 * dp) = (f32x2){r0, r1};
    __syncthreads();
    o.pre0 = o.pre1 = o.tot0 = o.tot1 = o.mid0 = o.mid1 = 0.f;
#pragma unroll
    for (int q = 0; q < 8; ++q) { const f32x2 p = *(const LAS f32x2*)(PART + q * 128 + 2 * dp); if (q < oct) { o.pre0 += p.x; o.pre1 += p.y; } if (q < 4) { o.mid0 += p.x; o.mid1 += p.y; } o.tot0 += p.x; o.tot1 += p.y; }
}

__device__ __forceinline__ size_t unit_goff(int unit) { const int b = unit >> 10, h = (unit >> 7) & 7, c = unit & 127; return (size_t)(b * SEQ + c * CH) * 1024 + h * HD; }
__device__ __forceinline__ void hgrn_pass1_phase(LAS unsigned char* lds, int bx, int G, const bf16_t* Kk, const bf16_t* LF, const bf16_t* V, bf16_t* S, float* DEC, int tid) {
    LAS unsigned char* TK = lds; LAS unsigned char* TL = lds + 16384; LAS unsigned char* TV = lds + 32768; LAS float* PART = (LAS float*)(lds + 49152);
    const int dp = tid & 63, oct = tid >> 6;
    const unsigned lane = tid & 63, wave = tid >> 6, fr = lane & 15, g4 = lane >> 4;
    u32x4 rk[2], rl[2], rv[2];
    if (bx < NUNIT) { const size_t go = unit_goff(bx); tile64_ld(Kk + go, rk, tid); tile64_ld(LF + go, rl, tid); tile64_ld(V + go, rv, tid);
        tile64_st(rk, TK, tid); tile64_st(rl, TL, tid); tile64_st(rv, TV, tid); }
    for (int unit = bx; unit < NUNIT; unit += G) {
        __syncthreads();
        if (unit + G < NUNIT) { const size_t go = unit_goff(unit + G); tile64_ld(Kk + go, rk, tid); tile64_ld(LF + go, rl, tid); tile64_ld(V + go, rv, tid); }
        ScanOut sc; chunk_scan(TL, PART, dp, oct, sc);
#pragma unroll
        for (int i = 0; i < 8; ++i) { LAS unsigned* p = (LAS unsigned*)(TK + off_b(8 * oct + i, dp >> 2) + 4 * (dp & 3)); const unsigned w = *p;
            const float e0 = __expf(sc.tot0 - (sc.pre0 + sc.cl[i][0])), e1 = __expf(sc.tot1 - (sc.pre1 + sc.cl[i][1]));
            *p = pk2(bflo(w) * e0, bfhi(w) * e1); }
        if (oct == 0) *(f32x2*)(DEC + (size_t)unit * HD + 2 * dp) = (f32x2){__expf(sc.tot0), __expf(sc.tot1)};
        __syncthreads();
        f32x4 acc[8];
#pragma unroll
        for (int cb = 0; cb < 8; ++cb) acc[cb] = (f32x4){0.f, 0.f, 0.f, 0.f};
#pragma unroll
        for (int ks = 0; ks < 2; ++ks) { const bf16x8 bk = tile_tr(TK, lane, wave, ks);
#pragma unroll
            for (int cb = 0; cb < 8; ++cb) { const bf16x8 av = tile_tr(TV, lane, cb, ks); acc[cb] = mfma16(av, bk, acc[cb]); } }
        __syncthreads();
        if (unit + G < NUNIT) { tile64_st(rk, TK, tid); tile64_st(rl, TL, tid); tile64_st(rv, TV, tid); }
        bf16_t* sp = S + (size_t)unit * (HD * HD) + (16 * wave + fr) * HD + 4 * g4;
#pragma unroll
        for (int cb = 0; cb < 8; ++cb) { u32x2 w; w.x = pk2(acc[cb][0], acc[cb][1]); w.y = pk2(acc[cb][2], acc[cb][3]); *(u32x2*)(sp + 16 * cb) = w; }
    }
}

__device__ __forceinline__ void pool_ld(const bf16_t* U, int pu, u32x4 (&r)[5], int tid) {
    const int tile = pu >> 2, gi = pu & 3, row0 = tile * 64, w = 2 << gi, pos0 = row0 & (SEQ - 1), nrow = 64 + w - 1;
    const bf16_t* ug = U + ((ptrdiff_t)row0 - (w - 1)) * 1024 + 256 * gi;
#pragma unroll
    for (int it = 0; it < 5; ++it) { const int n = tid + NTHR * it, rr = n >> 5, ch = n & 31; r[it] = (u32x4){0u, 0u, 0u, 0u};
        if (n < nrow * 32 && pos0 - (w - 1) + rr >= 0) r[it] = *(const u32x4*)(ug + (ptrdiff_t)rr * 1024 + ch * 8); }
}
__device__ __forceinline__ void pool_phase(LAS unsigned char* lds, int bx, int G, const bf16_t* U, const bf16_t* WpT, const float* pscale, bf16_t* YCAT, int tid) {
    LAS unsigned char* TP = lds;
    LAS unsigned char* TU = lds + 33792;
    const unsigned lane = tid & 63, wave = tid >> 6, fr = lane & 15, g4 = lane >> 4;
    const int cp = tid & 127, tq = tid >> 7, tbeg = 16 * tq;
    bf16x8 wa[8][2]; int wgi = -1;
    u32x4 ru[5];
    if (bx < NPOOLU) pool_ld(U, bx, ru, tid);
    for (int pu = bx; pu < NPOOLU; pu += G) {
        const int tile = pu >> 2, gi = pu & 3, row0 = tile * 64, w = 2 << gi, pos0 = row0 & (SEQ - 1), nrow = 64 + w - 1;
#pragma unroll
        for (int it = 0; it < 5; ++it) { const int n = tid + NTHR * it, rr = n >> 5, ch = n & 31; if (n < nrow * 32) *(LAS u32x4*)(TU + rr * 528 + ch * 16) = ru[it]; }
        __syncthreads();
        if (pu + G < NPOOLU) pool_ld(U, pu + G, ru, tid);
        if (gi != wgi) { wgi = gi; const bf16_t* wb = WpT + (size_t)gi * 65536 + (size_t)(32 * wave + fr) * 256 + 8 * g4;
#pragma unroll
            for (int ks = 0; ks < 8; ++ks)
#pragma unroll
                for (int nbi = 0; nbi < 2; ++nbi) wa[ks][nbi] = *(const bf16x8*)(wb + nbi * 16 * 256 + 32 * ks); }
        {   const LAS unsigned char* tu = TU + (w - 1) * 528 + cp * 4;
            float r0 = 0.f, r1 = 0.f;
            for (int j = 1; j < w; ++j) { const unsigned x = *(const LAS unsigned*)(tu + (tbeg - j) * 528); r0 += bflo(x); r1 += bfhi(x); }
#pragma unroll 4
            for (int i = 0; i < 16; ++i) { const int t = tbeg + i; const unsigned x = *(const LAS unsigned*)(tu + t * 528); const float c0 = bflo(x), c1 = bfhi(x);
                r0 += c0; r1 += c1; const int cn = pos0 + t + 1; const float inv = 1.0f / (float)(cn < w ? cn : w);
                *(LAS unsigned*)(TP + t * 528 + cp * 4) = pk2(r0 * inv - c0, r1 * inv - c1);
                const unsigned xo = *(const LAS unsigned*)(tu + (t - w + 1) * 528); r0 -= bflo(xo); r1 -= bfhi(xo); } }
        __syncthreads();
        f32x4 acc[2][4];
#pragma unroll
        for (int a = 0; a < 2; ++a)
#pragma unroll
            for (int t = 0; t < 4; ++t) acc[a][t] = (f32x4){0.f, 0.f, 0.f, 0.f};
#pragma unroll
        for (int ks = 0; ks < 8; ++ks) {
            bf16x8 bq[4];
#pragma unroll
            for (int tb = 0; tb < 4; ++tb) bq[tb] = *(const LAS bf16x8*)(TP + (16 * tb + fr) * 528 + 64 * ks + 16 * g4);
#pragma unroll
            for (int nbi = 0; nbi < 2; ++nbi)
#pragma unroll
                for (int tb = 0; tb < 4; ++tb) acc[nbi][tb] = mfma16(wa[ks][nbi], bq[tb], acc[nbi][tb]);
        }
#pragma unroll
        for (int nbi = 0; nbi < 2; ++nbi) { const int n = 32 * wave + 16 * nbi + 4 * g4; const f32x4 sc = *(const f32x4*)(pscale + 256 * gi + n);
#pragma unroll
            for (int tb = 0; tb < 4; ++tb) { const f32x4 o = acc[nbi][tb] * sc; u32x2 wv; wv.x = pk2(o[0], o[1]); wv.y = pk2(o[2], o[3]);
                *(u32x2*)(YCAT + (size_t)(row0 + 16 * tb + fr) * DM + DH + 256 * gi + n) = wv; } }
        __syncthreads();
    }
}

#ifndef SCAN_U
#define SCAN_U 8
#endif
__device__ __forceinline__ void hgrn_scan(bf16_t* S, const float* DEC, int gtid, int gthreads) {
    for (int idx = gtid; idx < BATCH * NH * HD * HD / 4; idx += gthreads) {
        const int bh = idx >> 12, rem = idx & 4095, dk = rem >> 5;
        bf16_t* sp = S + (size_t)bh * NCH * (HD * HD) + rem * 4; const float* dp = DEC + (size_t)bh * NCH * HD + dk;
        f32x4 s = (f32x4){0.f, 0.f, 0.f, 0.f};
        for (int c0 = 0; c0 < NCH; c0 += SCAN_U) {
            u32x2 bw[SCAN_U]; float d[SCAN_U];
#pragma unroll
            for (int i = 0; i < SCAN_U; ++i) { bw[i] = *(const u32x2*)(sp + (size_t)(c0 + i) * (HD * HD)); d[i] = dp[(c0 + i) * HD]; }
#pragma unroll
            for (int i = 0; i < SCAN_U; ++i) { u32x2 o; o.x = pk2(s[0], s[1]); o.y = pk2(s[2], s[3]); *(u32x2*)(sp + (size_t)(c0 + i) * (HD * HD)) = o;
                s = s * d[i] + (f32x4){bflo(bw[i].x), bfhi(bw[i].x), bflo(bw[i].y), bfhi(bw[i].y)}; }
        }
    }
}

__device__ __forceinline__ void state_ld(const bf16_t* sg, u32x4 (&r)[4], int tid) {
#pragma unroll
    for (int it = 0; it < 4; ++it) { const int n = tid + NTHR * it, row = n >> 4, ch = n & 15; r[it] = *(const u32x4*)(sg + row * HD + ch * 8); }
}
__device__ __forceinline__ void hgrn_pass3_phase(LAS unsigned char* lds, int bx, int G, const bf16_t* Q, const bf16_t* Kk, const bf16_t* LF, const bf16_t* V, const bf16_t* Gt, const bf16_t* S,
                                                 const float* gnorm, bf16_t* YCAT, int tid) {
    LAS unsigned char* TQ = lds; LAS unsigned char* TK = lds + 16384; LAS unsigned char* TL = lds + 32768; LAS unsigned char* TV = lds + 49152; LAS unsigned char* TS = lds + 65536;
    LAS unsigned char* TA = lds + 98304; LAS float* PART = (LAS float*)(lds + 108544); LAS float* RED = (LAS float*)(lds + 112640); LAS unsigned char* TG = lds + 114688;
    const int dp = tid & 63, oct = tid >> 6;
    const unsigned lane = tid & 63, wave = tid >> 6, fr = lane & 15, g4 = lane >> 4;
    f32x4 gn[4];
#pragma unroll
    for (int cb = 0; cb < 4; ++cb) gn[cb] = *(const f32x4*)(gnorm + 16 * (4 * (wave >> 2) + cb) + 4 * g4);
    u32x4 rq[2], rk[2], rl[2], rv[2], rs[4], rg[2];
    if (bx < NUNIT) { const size_t go = unit_goff(bx); tile64_ld(Q + go, rq, tid); tile64_ld(Kk + go, rk, tid); tile64_ld(LF + go, rl, tid); tile64_ld(V + go, rv, tid); tile64_ld(Gt + go, rg, tid); state_ld(S + (size_t)bx * (HD * HD), rs, tid);
        tile64_st(rq, TQ, tid); tile64_st(rk, TK, tid); tile64_st(rl, TL, tid); tile64_st(rv, TV, tid); tile64_st(rg, TG, tid);
#pragma unroll
        for (int it = 0; it < 4; ++it) { const int n = tid + NTHR * it, row = n >> 4, ch = n & 15; *(LAS u32x4*)(TS + off_b(row, ch)) = rs[it]; } }
    for (int unit = bx; unit < NUNIT; unit += G) {
        const int b = unit >> 10, h = (unit >> 7) & 7, c = unit & 127;
        const int row0 = b * SEQ + c * CH;
        __syncthreads();
        if (unit + G < NUNIT) { const size_t go = unit_goff(unit + G); tile64_ld(Q + go, rq, tid); tile64_ld(Kk + go, rk, tid); tile64_ld(LF + go, rl, tid); tile64_ld(V + go, rv, tid); tile64_ld(Gt + go, rg, tid); state_ld(S + (size_t)(unit + G) * (HD * HD), rs, tid); }
        ScanOut sc; chunk_scan(TL, PART, dp, oct, sc);
#pragma unroll
        for (int i = 0; i < 8; ++i) { const unsigned o = off_b(8 * oct + i, dp >> 2) + 4 * (dp & 3);
            const unsigned qw = *(const LAS unsigned*)(TQ + o), kw = *(const LAS unsigned*)(TK + o);
            const float c0 = sc.pre0 + sc.cl[i][0], c1 = sc.pre1 + sc.cl[i][1];
            const float q0 = bflo(qw), q1 = bfhi(qw);
            *(LAS unsigned*)(TQ + o) = pk2(q0 * __expf(c0 - sc.mid0), q1 * __expf(c1 - sc.mid1));
            *(LAS unsigned*)(TK + o) = pk2(bflo(kw) * __expf(sc.mid0 - c0), bfhi(kw) * __expf(sc.mid1 - c1));
            *(LAS unsigned*)(TL + o) = pk2(q0 * __expf(c0), q1 * __expf(c1)); }
        __syncthreads();
        {
            const unsigned tb = wave >> 1;
#pragma unroll
            for (int sbi = 0; sbi < 2; ++sbi) { const unsigned sb = 2 * (wave & 1) + sbi; f32x4 a = (f32x4){0.f, 0.f, 0.f, 0.f};
#pragma unroll
                for (int ks = 0; ks < 4; ++ks) a = mfma16(tile_row(TK, lane, sb, ks), tile_row(TQ, lane, tb, ks), a);
                const int t = 16 * tb + fr, s0 = 16 * sb + 4 * g4;
                u32x2 w; w.x = pk2(s0 <= t ? a[0] : 0.f, s0 + 1 <= t ? a[1] : 0.f); w.y = pk2(s0 + 2 <= t ? a[2] : 0.f, s0 + 3 <= t ? a[3] : 0.f);
                *(LAS u32x2*)(TA + t * 144 + s0 * 2) = w; }
        }
        __syncthreads();
        const unsigned tb = wave & 3, dvh = wave >> 2;
        const int t = 16 * tb + fr;
        f32x4 acc[4];
#pragma unroll
        for (int cb = 0; cb < 4; ++cb) acc[cb] = (f32x4){0.f, 0.f, 0.f, 0.f};
#pragma unroll
        for (int ks = 0; ks < 2; ++ks) { const bf16x8 bq = *(const LAS bf16x8*)(TA + (16 * tb + fr) * 144 + 64 * ks + 16 * g4);
#pragma unroll
            for (int cb = 0; cb < 4; ++cb) acc[cb] = mfma16(tile_tr(TV, lane, 4 * dvh + cb, ks), bq, acc[cb]); }
#pragma unroll
        for (int ks = 0; ks < 4; ++ks) { const bf16x8 bq = tile_row(TL, lane, tb, ks);
#pragma unroll
            for (int cb = 0; cb < 4; ++cb) acc[cb] = mfma16(tile_tr(TS, lane, 4 * dvh + cb, ks), bq, acc[cb]); }
        float ss = 0.f;
#pragma unroll
        for (int cb = 0; cb < 4; ++cb) ss += (acc[cb][0] * acc[cb][0] + acc[cb][1] * acc[cb][1]) + (acc[cb][2] * acc[cb][2] + acc[cb][3] * acc[cb][3]);
        ss += __shfl_xor(ss, 16); ss += __shfl_xor(ss, 32);
        if (g4 == 0) RED[dvh * 64 + 16 * tb + fr] = ss;
        __syncthreads();
        const float r = rsqrtf((RED[16 * tb + fr] + RED[64 + 16 * tb + fr]) * (1.f / HD) + RMS_EPS);
        u32x2 wv[4];
#pragma unroll
        for (int cb = 0; cb < 4; ++cb) { const int dv = 16 * (4 * dvh + cb) + 4 * g4;
            const u32x2 gw = *(const LAS u32x2*)(TG + off_b(t, dv >> 3) + 2 * (dv & 7));
            const f32x4 sg = (f32x4){bflo(gw.x), bfhi(gw.x), bflo(gw.y), bfhi(gw.y)};
            const f32x4 o = acc[cb] * r * gn[cb] * sg; wv[cb].x = pk2(o[0], o[1]); wv[cb].y = pk2(o[2], o[3]); }
        __syncthreads();
        if (unit + G < NUNIT) { tile64_st(rq, TQ, tid); tile64_st(rk, TK, tid); tile64_st(rl, TL, tid); tile64_st(rv, TV, tid); tile64_st(rg, TG, tid);
#pragma unroll
            for (int it = 0; it < 4; ++it) { const int n = tid + NTHR * it, row = n >> 4, ch = n & 15; *(LAS u32x4*)(TS + off_b(row, ch)) = rs[it]; } }
#pragma unroll
        for (int cb = 0; cb < 4; ++cb) *(u32x2*)(YCAT + (size_t)(row0 + t) * DM + h * HD + 16 * (4 * dvh + cb) + 4 * g4) = wv[cb];
    }
}
#define XB_TMO      128
#define XB_XCNT(j)  (256  + 64 * (j))
#define XB_XSUB(j)  (1280 + 64 * (j))
#define XB_XGEN(j)  (2304 + 64 * (j))
#define XB_TOP      3328
#define XB_TOPGEN   3392
#define XCD_BAR_WORDS 3456
#define XB_SPIN_CAP (1u << 18)

__device__ __forceinline__ unsigned xb_ld(unsigned* p)              { return __hip_atomic_load(p, __ATOMIC_RELAXED, __HIP_MEMORY_SCOPE_AGENT); }
__device__ __forceinline__ unsigned xb_add(unsigned* p, unsigned v) { return __hip_atomic_fetch_add(p, v, __ATOMIC_RELAXED, __HIP_MEMORY_SCOPE_AGENT); }
__device__ __forceinline__ unsigned xb_xcc_id() { return (unsigned)__builtin_amdgcn_s_getreg((3 << 11) | 20) & 0xFu; }
#define XB_SPIN(cond, bar) do { unsigned _sp = 0; while (cond) { __builtin_amdgcn_s_sleep(1); \
    if ((++_sp & 255u) == 0u) { if (xb_ld(&(bar)[XB_TMO])) break; if (_sp > XB_SPIN_CAP) { atomicAdd(&(bar)[XB_TMO], 1u); break; } } } } while (0)

struct XcdBarrier {
    unsigned* bar; unsigned x;
    volatile LAS unsigned* st;
};

__device__ __forceinline__ XcdBarrier xcd_barrier_post(unsigned* bar, volatile LAS unsigned* st) {
    XcdBarrier b; b.bar = bar; b.x = xb_xcc_id(); b.st = st;
    if (threadIdx.x == 0) (void)xb_add(&bar[XB_XCNT(b.x)], 1u);
    return b;
}
__device__ __forceinline__ void xcd_barrier_complete(unsigned* bar, unsigned x, unsigned& nloc, unsigned& nx) {
    const unsigned G = gridDim.x * gridDim.y * gridDim.z;
    unsigned sum, cnt, mine, sp = 0u;
    for (;;) {
        sum = 0u; cnt = 0u; mine = 0u;
#pragma unroll
        for (unsigned j = 0; j < 16; ++j) { const unsigned c = xb_ld(&bar[XB_XCNT(j)]); sum += c; cnt += (c > 0u) ? 1u : 0u; mine = (j == x) ? c : mine; }
        if (sum == G) break;
        __builtin_amdgcn_s_sleep(1);
        if ((++sp & 255u) == 0u) { if (xb_ld(&bar[XB_TMO])) break; if (sp > XB_SPIN_CAP) { atomicAdd(&bar[XB_TMO], 1u); break; } }
    }
    nloc = mine > 0u ? mine : 1u; nx = cnt > 0u ? cnt : 1u;
}

__device__ __forceinline__ void xcd_barrier(const XcdBarrier& b) {
    asm volatile("s_waitcnt vmcnt(0)" ::: "memory");
    __syncthreads();
    if (threadIdx.x == 0) {
        unsigned* bar = b.bar;
        __builtin_amdgcn_s_waitcnt(0);
        unsigned nloc = b.st[0], nx = b.st[1];
        if (nloc == 0u) { xcd_barrier_complete(bar, b.x, nloc, nx); b.st[0] = nloc; b.st[1] = nx; }
        const unsigned old = xb_add(&bar[XB_XSUB(b.x)], 1u);
        const unsigned gen = old / nloc;
        if (old + 1u == (gen + 1u) * nloc) {
            __builtin_amdgcn_fence(__ATOMIC_RELEASE, "agent");
            asm volatile("s_waitcnt vmcnt(0)" ::: "memory");
            const unsigned og = xb_add(&bar[XB_TOP], 1u);
            const unsigned tg = og / nx;
            if (og + 1u == (tg + 1u) * nx) xb_add(&bar[XB_TOPGEN], 1u);
            else XB_SPIN(xb_ld(&bar[XB_TOPGEN]) == tg, bar);
            __builtin_amdgcn_fence(__ATOMIC_ACQUIRE, "agent");
            xb_add(&bar[XB_XGEN(b.x)], 1u);
            asm volatile("s_waitcnt vmcnt(0)" ::: "memory");
        } else {
            XB_SPIN(xb_ld(&bar[XB_XGEN(b.x)]) == gen, bar);
            __builtin_amdgcn_fence(__ATOMIC_ACQUIRE, "agent");
            asm volatile("s_waitcnt vmcnt(0)" ::: "memory");
        }
    }
    __syncthreads();
}

#ifndef MK_N_LAUNCHES
#define MK_N_LAUNCHES 1
#endif
#ifndef WGM_GU
#define WGM_GU 4
#endif
#ifndef WGM_D
#define WGM_D 4
#endif
#ifndef WGM_IN
#define WGM_IN 4
#endif
#ifndef WGM_OUT
#define WGM_OUT 4
#endif
constexpr int N_PHASES = 13;
struct Params { const float* in[19]; float* out; unsigned char* ws; int ph_lo, ph_hi, li, pad; };
__global__ void __launch_bounds__(NTHR, 2) fwd_megakernel(Params p) {
    extern __shared__ __attribute__((aligned(16))) unsigned char lds_raw[];
    LAS unsigned char* lds = (LAS unsigned char*)lds_raw;
    cg::grid_group grid = cg::this_grid();
    const int tid = threadIdx.x, lane = tid & 63, wave = __builtin_amdgcn_readfirstlane(tid >> 6);
    const int G = gridDim.x, bx = blockIdx.x;
    const int gw = bx * NWAVES + wave, NGW = G * NWAVES;
    unsigned char* ws = p.ws;
    const float* x = p.in[0];
    bf16_t* Wgu1 = (bf16_t*)(ws + WS_WGU1); bf16_t* Wd1 = (bf16_t*)(ws + WS_WD1); bf16_t* Win = (bf16_t*)(ws + WS_WIN); bf16_t* Wout = (bf16_t*)(ws + WS_WOUT);
    bf16_t* Wpool = (bf16_t*)(ws + WS_WPOOL); bf16_t* Wgu2 = (bf16_t*)(ws + WS_WGU2); bf16_t* Wd2 = (bf16_t*)(ws + WS_WD2);
    bf16_t* Hb = (bf16_t*)(ws + WS_H); bf16_t* Yb = (bf16_t*)(ws + WS_Y); bf16_t* XN = (bf16_t*)(ws + WS_XN); bf16_t* YCAT = (bf16_t*)(ws + WS_YCAT);
    bf16_t* Qb = (bf16_t*)(ws + WS_Q); bf16_t* Kb = (bf16_t*)(ws + WS_K); bf16_t* LFb = (bf16_t*)(ws + WS_LF); bf16_t* Vb = (bf16_t*)(ws + WS_V); bf16_t* Gb = (bf16_t*)(ws + WS_G);
    bf16_t* Ub = (bf16_t*)(ws + WS_U); bf16_t* Sb = (bf16_t*)(ws + WS_S); float* DEC = (float*)(ws + WS_DEC); float* RS = (float*)(ws + WS_RS);
    const int lo = p.ph_lo, hi = p.ph_hi;
#define IN(k) (lo <= (k) && (k) < hi)
#define SEAM(k) do { if (IN(k) && IN((k) + 1)) xcd_barrier(bar); } while (0)
    volatile LAS unsigned* bst = (volatile LAS unsigned*)(lds + LDS_BYTES - 64);
    if (tid < 16) bst[tid] = 0u;
    __syncthreads();
    XcdBarrier bar; bar.bar = (unsigned*)ws + p.li * XCD_BAR_WORDS; bar.x = 0; bar.st = nullptr;
    if (hi - lo > 1) bar = xcd_barrier_post((unsigned*)ws + p.li * XCD_BAR_WORDS, bst);
    if (lo == -12345) grid.sync();

    if (IN(0)) {
        LAS float* scr = (LAS float*)(lds + wave * P0_SCR_BYTES);
        constexpr int I_GU = (DM / 64) * (FF / 64), I_D = (FF / 64) * (DM / 64), I_IN = (DM / 64) * (DIN / 64), I_OUT = (DM / 64) * (DM / 64), I_P = (256 / 64) * (256 / 64);
        static_assert(NWAVES * P0_SCR_BYTES <= LDS_BYTES - 64, "prologue scratch");
        constexpr int NITEMS = 4 * I_GU + 2 * I_D + I_IN + I_OUT + 4 * I_P;
        for (int it = gw; it < NITEMS; it += NGW) {
            int r = it;
            if (r < I_GU) { p0_matrix_item(p.in[2], DM, FF, Wgu1, 1, r, scr, lane, p.in[1]); continue; } r -= I_GU;
            if (r < I_GU) { p0_matrix_item(p.in[3], DM, FF, Wgu1, 2, r, scr, lane, p.in[1]); continue; } r -= I_GU;
            if (r < I_D) { p0_matrix_item(p.in[4], FF, DM, Wd1, 0, r, scr, lane); continue; } r -= I_D;
            if (r < I_IN) { p0_matrix_item(p.in[7], DM, DIN, Win, 0, r, scr, lane, p.in[6]); continue; } r -= I_IN;
            if (r < I_OUT) { p0_matrix_item(p.in[12], DM, DM, Wout, 0, r, scr, lane); continue; } r -= I_OUT;
            if (r < 4 * I_P) { const int gi = r / I_P; p0_matrix_item(p.in[10] + (size_t)gi * 65536, 256, 256, Wpool + (size_t)gi * 65536, 0, r % I_P, scr, lane); continue; } r -= 4 * I_P;
            if (r < I_GU) { p0_matrix_item(p.in[15], DM, FF, Wgu2, 1, r, scr, lane, p.in[14]); continue; } r -= I_GU;
            if (r < I_GU) { p0_matrix_item(p.in[16], DM, FF, Wgu2, 2, r, scr, lane, p.in[14]); continue; } r -= I_GU;
            p0_matrix_item(p.in[17], FF, DM, Wd2, 0, r, scr, lane);
        }
        rows_first(x, XN, RS, gw, NGW, lane);
        __syncthreads();
    }
    SEAM(0);
    if (IN(1)) { pg8::Gemm g{XN, Wgu1, M, 2 * FF, DM}; pg8::StaticOrder S; S.init(M, 2 * FF, G, bx, WGM_GU); pg8::EpiSwiglu E{Hb, FF, RS};
        pg8::gemm_phase<pg8::EpiSwiglu, pg8::StaticOrder, true, true>(lds, g, S, E); }
    SEAM(1);
    if (IN(2)) { pg8::Gemm g{Hb, Wd1, M, DM, FF}; pg8::StaticOrder S; S.init(M, DM, G, bx, WGM_D); pg8::EpiStore E{Yb, DM};
        pg8::gemm_phase<pg8::EpiStore, pg8::StaticOrder, true, true>(lds, g, S, E); }
    SEAM(2);
    if (IN(3)) rows_res<false>(x, Yb, 0.5f, p.in[5], XN, RS, nullptr, gw, NGW, lane);
    SEAM(3);
    if (IN(4)) { pg8::Gemm g{XN, Win, M, DIN, DM}; pg8::StaticOrder S; S.init(M, DIN, G, bx, WGM_IN); pg8::EpiWin E{Qb, Kb, LFb, Vb, Gb, Ub, p.in[8], RS};
        pg8::gemm_phase<pg8::EpiWin, pg8::StaticOrder, true, true>(lds, g, S, E); }
    SEAM(4);
    if (IN(5)) {
        hgrn_pass1_phase(lds, bx, G, Kb, LFb, Vb, Sb, DEC, tid);
        pool_phase(lds, bx, G, Ub, Wpool, p.in[11], YCAT, tid);
    }
    SEAM(5);
    if (IN(6)) hgrn_scan(Sb, DEC, bx * NTHR + tid, G * NTHR);
    SEAM(6);
    if (IN(7)) hgrn_pass3_phase(lds, bx, G, Qb, Kb, LFb, Vb, Gb, Sb, p.in[9], YCAT, tid);
    SEAM(7);
    if (IN(8)) { pg8::Gemm g{YCAT, Wout, M, DM, DM}; pg8::StaticOrder S; S.init(M, DM, G, bx, WGM_OUT); pg8::EpiStore E{Yb, DM};
        pg8::gemm_phase<pg8::EpiStore, pg8::StaticOrder, true, true>(lds, g, S, E); }
    SEAM(8);
    if (IN(9)) rows_res<false>(nullptr, Yb, 1.0f, p.in[13], XN, RS, nullptr, gw, NGW, lane);
    SEAM(9);
    if (IN(10)) { pg8::Gemm g{XN, Wgu2, M, 2 * FF, DM}; pg8::StaticOrder S; S.init(M, 2 * FF, G, bx, WGM_GU); pg8::EpiSwiglu E{Hb, FF, RS};
        pg8::gemm_phase<pg8::EpiSwiglu, pg8::StaticOrder, true, true>(lds, g, S, E); }
    SEAM(10);
    if (IN(11)) { pg8::Gemm g{Hb, Wd2, M, DM, FF}; pg8::StaticOrder S; S.init(M, DM, G, bx, WGM_D); pg8::EpiStore E{Yb, DM};
        pg8::gemm_phase<pg8::EpiStore, pg8::StaticOrder, true, true>(lds, g, S, E); }
    SEAM(11);
    if (IN(12)) rows_res<true>(nullptr, Yb, 0.5f, p.in[18], XN, nullptr, p.out, gw, NGW, lane);
#undef IN
#undef SEAM
}

extern "C" void kernel_launch(void* const* d_in, const int* in_sizes, int n_in, void* d_out, int out_size, void* d_ws, size_t ws_size, hipStream_t stream) {
    static int grid = 0;
    if (grid == 0) {
        if (n_in != 19 || in_sizes[0] != M * DM || out_size != M * DM || ws_size < WS_END) { fprintf(stderr, "kernel_launch: unexpected shapes (n_in %d in0 %d out %d ws %zu)\n", n_in, n_in > 0 ? in_sizes[0] : -1, out_size, ws_size); grid = -1; return; }
        int dev = 0, cus = 0, per_cu = 0;
        (void)hipGetDevice(&dev); (void)hipDeviceGetAttribute(&cus, hipDeviceAttributeMultiprocessorCount, dev);
        if (hipFuncSetAttribute((const void*)fwd_megakernel, hipFuncAttributeMaxDynamicSharedMemorySize, LDS_BYTES) != hipSuccess) { fprintf(stderr, "kernel_launch: hipFuncSetAttribute failed\n"); grid = -1; return; }
        if (hipOccupancyMaxActiveBlocksPerMultiprocessor(&per_cu, (const void*)fwd_megakernel, NTHR, LDS_BYTES) != hipSuccess || per_cu < 1) { fprintf(stderr, "kernel_launch: occupancy query says %d\n", per_cu); per_cu = 1; }
        (void)hipGetLastError();
        grid = cus * per_cu;
    }
    if (grid < 0) return;
    Params p{};
    for (int i = 0; i < 19; ++i) p.in[i] = (const float*)d_in[i];
    p.out = (float*)d_out; p.ws = (unsigned char*)d_ws;
#if MK_N_LAUNCHES == 1
    (void)hipMemsetAsync(d_ws, 0, 65536, stream);
    void* args[] = {&p};
#ifdef PROBE_PHASE
#ifndef PROBE_END
#define PROBE_END PROBE_PHASE
#endif
    p.ph_lo = 0; p.ph_hi = PROBE_END + 1;
    (void)hipLaunchCooperativeKernel((const void*)fwd_megakernel, dim3(grid), dim3(NTHR), args, LDS_BYTES, stream);
    p.ph_lo = PROBE_PHASE; p.ph_hi = PROBE_END + 1; p.li = 1;
    (void)hipLaunchCooperativeKernel((const void*)fwd_megakernel, dim3(grid), dim3(NTHR), args, LDS_BYTES, stream);
    p.ph_lo = PROBE_END + 1; p.ph_hi = N_PHASES; p.li = 2;
    (void)hipLaunchCooperativeKernel((const void*)fwd_megakernel, dim3(grid), dim3(NTHR), args, LDS_BYTES, stream);
#else
    p.ph_lo = 0; p.ph_hi = N_PHASES;
    hipError_t e = hipLaunchCooperativeKernel((const void*)fwd_megakernel, dim3(grid), dim3(NTHR), args, LDS_BYTES, stream);
    if (e != hipSuccess) fprintf(stderr, "cooperative launch failed: %s (grid %d)\n", hipGetErrorString(e), grid);
#endif
#else
    for (int ph = 0; ph < N_PHASES; ++ph) { p.ph_lo = ph; p.ph_hi = ph + 1; hipLaunchKernelGGL(fwd_megakernel, dim3(grid), dim3(NTHR), LDS_BYTES, stream, p); }
#endif
}
```
